# Optimizing an MI355X kernel written in HIP

```python
import math
import jax, jax.numpy as jnp
from jax import lax
import numpy as np

D_MODEL = 1024
BATCH = 2
SEQ = 8192
DEPTH = 1

MEM_LEN = 256
MLA_NOPE = 128
MLA_ROPE = 64
MLA_V = 128
MLA_HEADS = D_MODEL // MLA_V
MLA_KV_RANK = 256
GLA_HEADS = 4
GLA_DK = D_MODEL // 2 // GLA_HEADS
GLA_DV = D_MODEL // GLA_HEADS
GLA_GATE_RANK = 16
GLA_GATE_NORMALIZER = 16.0
GLA_CHUNK = 64
MEM_HEADS = 4
MEM_DQK = 64
MEM_DV = D_MODEL // MEM_HEADS
N_BRANCHES = 3
D_FF = 4 * D_MODEL
ATTN_BLOCK = 128
ROPE_THETA = 10000.0
EPS = 1e-6

IN_SPLITS = (
    MLA_HEADS * (MLA_NOPE + MLA_ROPE),
    MLA_KV_RANK,
    MLA_ROPE,
    GLA_HEADS * GLA_DK,
    GLA_HEADS * GLA_DK,
    GLA_HEADS * GLA_DV,
    GLA_GATE_RANK,
    GLA_HEADS * GLA_DV,
    MEM_HEADS * MEM_DQK,
    N_BRANCHES * D_MODEL,
)
D_IN = sum(IN_SPLITS)

kernel_name = 'hybrid_mla_gla_mem_block'


def rms_norm(t, g):
    tf = t.astype(jnp.float32)
    y = tf * lax.rsqrt(jnp.mean(tf * tf, axis=-1, keepdims=True) + EPS)
    return (y * g.astype(jnp.float32)).astype(t.dtype)


def rope_tables(positions):
    inv = 1.0 / (ROPE_THETA ** (jnp.arange(0, MLA_ROPE, 2, dtype=jnp.float32) / MLA_ROPE))
    ang = positions.astype(jnp.float32)[..., None] * inv
    return jnp.cos(ang), jnp.sin(ang)


def apply_rope(t, cos, sin):
    tf = t.astype(jnp.float32)
    t1, t2 = jnp.split(tf, 2, axis=-1)
    c = cos[:, :, None, :]
    s = sin[:, :, None, :]
    return jnp.concatenate([t1 * c - t2 * s, t1 * s + t2 * c], axis=-1).astype(t.dtype)


def causal_block_attention(q, k, v, scale):
    B, S, H, D = q.shape
    Dv = v.shape[-1]
    nb = S // ATTN_BLOCK
    qb = q.reshape(B, nb, ATTN_BLOCK, H, D).transpose(1, 0, 3, 2, 4)
    kh = k.transpose(0, 2, 1, 3)
    vh = v.transpose(0, 2, 1, 3)
    kpos = jnp.arange(S)

    def one_block(args):
        qi, i = args
        s = jnp.einsum('bhqd,bhkd->bhqk', qi, kh).astype(jnp.float32) * scale
        qpos = i * ATTN_BLOCK + jnp.arange(ATTN_BLOCK)
        s = jnp.where(kpos[None, :] <= qpos[:, None], s, -1e30)
        p = jax.nn.softmax(s, axis=-1).astype(vh.dtype)
        return jnp.einsum('bhqk,bhkd->bhqd', p, vh)

    o = lax.map(one_block, (qb, jnp.arange(nb)))
    return o.transpose(1, 0, 3, 2, 4).reshape(B, S, H, Dv)


def gla_chunked(q, k, v, log_a):
    B, S, H, DK = q.shape
    DV = v.shape[-1]
    C = GLA_CHUNK
    nc = S // C

    def to_chunks(t):
        return t.astype(jnp.float32).reshape(B, nc, C, H, t.shape[-1]).transpose(1, 0, 3, 2, 4)

    qc, kc, vc = to_chunks(q), to_chunks(k), to_chunks(v)
    bc = jnp.cumsum(to_chunks(log_a), axis=3)
    mask = jnp.tril(jnp.ones((C, C), dtype=bool))[None, None, :, :, None]

    def step(state, inp):
        qi, ki, vi, bi = inp
        diff = bi[:, :, :, None, :] - bi[:, :, None, :, :]
        decay = jnp.where(mask, jnp.exp(jnp.where(mask, diff, 0.0)), 0.0)
        a = jnp.einsum('bhid,bhjd,bhijd->bhij', qi, ki, decay)
        o_intra = jnp.einsum('bhij,bhje->bhie', a, vi)
        o_inter = jnp.einsum('bhid,bhde->bhie', qi * jnp.exp(bi), state)
        b_last = bi[:, :, -1, :]
        k_dec = ki * jnp.exp(b_last[:, :, None, :] - bi)
        new_state = jnp.exp(b_last)[..., None] * state + jnp.einsum('bhjd,bhje->bhde', k_dec, vi)
        return new_state, o_intra + o_inter

    state0 = jnp.zeros((B, H, DK, DV), jnp.float32)
    _, o = lax.scan(step, state0, (qc, kc, vc, bc))
    return o.transpose(1, 0, 3, 2, 4).reshape(B, S, H, DV).astype(q.dtype)


def hybrid_layer(x, mem, cos, sin, g_mix, w_in, b_gate, g_ckv, w_ukv, g_q_nope, g_k_nope,
                 g_q_rope, g_k_rope, w_gla_gate, b_gla_gate, g_gla_out, g_mem, w_mem_kv,
                 g_q_mem, g_k_mem, w_o, g_ffn, w_up, w_down):
    B, S, _ = x.shape
    M = mem.shape[1]
    h = rms_norm(x, g_mix)
    proj = h @ w_in
    offsets = []
    acc = 0
    for n in IN_SPLITS[:-1]:
        acc += n
        offsets.append(acc)
    (q_mla, c_kv, k_rope, q_gla, k_gla, v_gla, a_gla, r_gla, q_mem,
     gate_logits) = jnp.split(proj, offsets, axis=-1)

    q_mla = q_mla.reshape(B, S, MLA_HEADS, MLA_NOPE + MLA_ROPE)
    q_nope = rms_norm(q_mla[..., :MLA_NOPE], g_q_nope)
    q_pe = apply_rope(rms_norm(q_mla[..., MLA_NOPE:], g_q_rope), cos, sin)
    kv = (rms_norm(c_kv, g_ckv) @ w_ukv).reshape(B, S, MLA_HEADS, MLA_NOPE + MLA_V)
    k_nope = rms_norm(kv[..., :MLA_NOPE], g_k_nope)
    v_mla = kv[..., MLA_NOPE:]
    k_pe = apply_rope(rms_norm(k_rope, g_k_rope)[:, :, None, :], cos, sin)
    q_full = jnp.concatenate([q_nope, q_pe], axis=-1)
    k_full = jnp.concatenate([k_nope, jnp.broadcast_to(k_pe, (B, S, MLA_HEADS, MLA_ROPE))], axis=-1)
    o_mla = causal_block_attention(q_full, k_full, v_mla,
                                   (MLA_NOPE + MLA_ROPE) ** -0.5).reshape(B, S, MLA_HEADS * MLA_V)

    qg = q_gla.reshape(B, S, GLA_HEADS, GLA_DK) * (GLA_DK ** -0.5)
    kg = k_gla.reshape(B, S, GLA_HEADS, GLA_DK)
    vg = v_gla.reshape(B, S, GLA_HEADS, GLA_DV)
    log_a = jax.nn.log_sigmoid((a_gla @ w_gla_gate + b_gla_gate).astype(jnp.float32)) / GLA_GATE_NORMALIZER
    log_a = log_a.reshape(B, S, GLA_HEADS, GLA_DK)
    og = gla_chunked(qg, kg, vg, log_a)
    o_gla = rms_norm(og, g_gla_out).reshape(B, S, GLA_HEADS * GLA_DV) * jax.nn.silu(r_gla)

    kv_m = rms_norm(mem, g_mem) @ w_mem_kv
    k_m = rms_norm(kv_m[..., :MEM_HEADS * MEM_DQK].reshape(B, M, MEM_HEADS, MEM_DQK), g_k_mem)
    v_m = kv_m[..., MEM_HEADS * MEM_DQK:].reshape(B, M, MEM_HEADS, MEM_DV)
    q_m = rms_norm(q_mem.reshape(B, S, MEM_HEADS, MEM_DQK), g_q_mem)
    s_m = jnp.einsum('bshd,bmhd->bhsm', q_m, k_m).astype(jnp.float32) * (MEM_DQK ** -0.5)
    p_m = jax.nn.softmax(s_m, axis=-1).astype(v_m.dtype)
    o_mem = jnp.einsum('bhsm,bmhd->bshd', p_m, v_m).reshape(B, S, MEM_HEADS * MEM_DV)

    gates = jax.nn.sigmoid(gate_logits + b_gate).reshape(B, S, N_BRANCHES, D_MODEL)
    y = gates[..., 0, :] * o_mla + gates[..., 1, :] * o_gla + gates[..., 2, :] * o_mem
    x = x + y @ w_o

    h2 = rms_norm(x, g_ffn)
    return x + jnp.square(jax.nn.relu(h2 @ w_up)) @ w_down


def setup_inputs(seed: int = 0) -> dict:
    key = jax.random.key(seed)
    ks = jax.random.split(key, 24)
    L = DEPTH

    def w(k, shape, fan_in):
        return jax.random.normal(k, (L,) + shape, jnp.float32) * (fan_in ** -0.5)

    def gain(k, n):
        return 1.0 + 0.02 * jax.random.normal(k, (L, n), jnp.float32)

    def bias(k, n):
        return 0.01 * jax.random.normal(k, (L, n), jnp.float32)

    x = jax.random.normal(ks[0], (BATCH, SEQ, D_MODEL), jnp.float32)
    mem = jax.random.normal(ks[1], (BATCH, MEM_LEN, D_MODEL), jnp.float32)
    positions = (jax.random.randint(ks[2], (BATCH, 1), 0, 4096, dtype=jnp.int32)
                 + jnp.arange(SEQ, dtype=jnp.int32)[None, :])
    return {
        'x': x,
        'mem': mem,
        'positions': positions,
        'g_mix': gain(ks[3], D_MODEL),
        'w_in': w(ks[4], (D_MODEL, D_IN), D_MODEL),
        'b_gate': bias(ks[5], N_BRANCHES * D_MODEL),
        'g_ckv': gain(ks[6], MLA_KV_RANK),
        'w_ukv': w(ks[7], (MLA_KV_RANK, MLA_HEADS * (MLA_NOPE + MLA_V)), MLA_KV_RANK),
        'g_q_nope': gain(ks[8], MLA_NOPE),
        'g_k_nope': gain(ks[9], MLA_NOPE),
        'g_q_rope': gain(ks[10], MLA_ROPE),
        'g_k_rope': gain(ks[11], MLA_ROPE),
        'w_gla_gate': w(ks[12], (GLA_GATE_RANK, GLA_HEADS * GLA_DK), GLA_GATE_RANK),
        'b_gla_gate': bias(ks[13], GLA_HEADS * GLA_DK),
        'g_gla_out': gain(ks[14], GLA_DV),
        'g_mem': gain(ks[15], D_MODEL),
        'w_mem_kv': w(ks[16], (D_MODEL, MEM_HEADS * (MEM_DQK + MEM_DV)), D_MODEL),
        'g_q_mem': gain(ks[17], MEM_DQK),
        'g_k_mem': gain(ks[18], MEM_DQK),
        'w_o': w(ks[19], (D_MODEL, D_MODEL), D_MODEL),
        'g_ffn': gain(ks[20], D_MODEL),
        'w_up': w(ks[21], (D_MODEL, D_FF), D_MODEL),
        'w_down': w(ks[22], (D_FF, D_MODEL), D_FF),
    }


def reference(x, mem, positions, g_mix, w_in, b_gate, g_ckv, w_ukv, g_q_nope, g_k_nope,
              g_q_rope, g_k_rope, w_gla_gate, b_gla_gate, g_gla_out, g_mem, w_mem_kv,
              g_q_mem, g_k_mem, w_o, g_ffn, w_up, w_down):
    cos, sin = rope_tables(positions)
    for l in range(DEPTH):
        x = hybrid_layer(x, mem, cos, sin, g_mix[l], w_in[l], b_gate[l], g_ckv[l], w_ukv[l],
                         g_q_nope[l], g_k_nope[l], g_q_rope[l], g_k_rope[l], w_gla_gate[l],
                         b_gla_gate[l], g_gla_out[l], g_mem[l], w_mem_kv[l], g_q_mem[l],
                         g_k_mem[l], w_o[l], g_ffn[l], w_up[l], w_down[l])
    return x
```

```cpp
#include <hip/hip_runtime.h>
#include <cstdio>
#include <cstdint>
#include <cmath>
namespace pg8 {
#define PG8_LAS __attribute__((address_space(3)))
typedef unsigned short bf16_t;
typedef short bf16x8 __attribute__((ext_vector_type(8)));
typedef float f32x4 __attribute__((ext_vector_type(4)));
typedef unsigned u32x4 __attribute__((ext_vector_type(4)));
constexpr int BM = 256, BK = 64, HALF = 128, HTB = HALF * BK * 2  , STAGE_BYTES = 8 * HTB, NXCD = 8, WGM = 8;

__host__ __device__ __forceinline__ int lds_byte(int r, int c) { const int st = (r >> 4) * 2 + (c >> 5), rr = r & 15, cc = c & 31, ob = rr * 64 + cc * 2; return st * 1024 + (ob ^ (((ob >> 9) & 1) << 5)); }
__host__ __device__ __forceinline__ void stage_rc(int b, int& R, int& C) { const int st = b / 1024, sb = b % 1024, swz = sb ^ (((sb >> 9) & 1) << 5); R = (st >> 1) * 16 + swz / 64; C = (st & 1) * 32 + (swz % 64) / 2; }
__host__ __device__ __forceinline__ int perm32(int rho) { const int n = rho >> 4, i = rho & 15; return 8 * (i >> 2) + 4 * n + (i & 3); }

struct Unit { int pm, pn; };
struct Gemm { const bf16_t* A; const bf16_t* Bt; int M, N, K; };

struct StaticOrder {
    int nM, nN, nwg, G, c;
    __host__ __device__ void init(int M, int N, int G_, int c_) { nM = M / BM; nN = N / BM; nwg = nM * nN; G = G_; c = c_; }
    __host__ __device__ bool next(int i, Unit& u) const {
        const long L = (long)i * G + c; if (L >= nwg) return false;
        int wgid = (int)L; { const int q = nwg / NXCD, r = nwg % NXCD, xcd = wgid % NXCD, off = wgid / NXCD; wgid = (xcd < r ? xcd * (q + 1) : r * (q + 1) + (xcd - r) * q) + off; }
        const int nig = WGM * nN, gid = wgid / nig, fm = gid * WGM, gsz = (nM - fm) < WGM ? (nM - fm) : WGM;
        u.pm = fm + ((wgid % nig) % gsz); u.pn = (wgid % nig) / gsz; return true;
    }
    __device__ __forceinline__ void a_ready(const Unit&) const {}
    __device__ __forceinline__ void done(const Unit&) const {}
};

__device__ __forceinline__ unsigned cvt_pk_bf16(float lo, float hi) { unsigned r; asm volatile("v_cvt_pk_bf16_f32 %0, %1, %2" : "=v"(r) : "v"(lo), "v"(hi)); return r; }
typedef float f32x2 __attribute__((ext_vector_type(2)));
__device__ __forceinline__ u32x4 pack8bf(const f32x4 v0, const f32x4 v1) { u32x4 w; w.x = cvt_pk_bf16(v0[0], v0[1]); w.y = cvt_pk_bf16(v0[2], v0[3]); w.z = cvt_pk_bf16(v1[0], v1[1]); w.w = cvt_pk_bf16(v1[2], v1[3]); return w; }
__device__ __forceinline__ float bflo(unsigned w) { return __uint_as_float(w << 16); }
__device__ __forceinline__ float bfhi(unsigned w) { return __uint_as_float(w & 0xffff0000u); }
__device__ __forceinline__ void unpack8bf(const u32x4 w, f32x4& a, f32x4& b) { a = (f32x4){bflo(w.x), bfhi(w.x), bflo(w.y), bfhi(w.y)}; b = (f32x4){bflo(w.z), bfhi(w.z), bflo(w.w), bfhi(w.w)}; }
__device__ __forceinline__ float sigmoidf_(float x) { return __builtin_amdgcn_rcpf(1.0f + __builtin_amdgcn_exp2f(-1.4426950408889634f * x)); }

struct EpiProj {
    static constexpr bool PERM = true, AFTER_DRAIN = false;
    bf16_t *Q, *CKV, *KRAG, *GQ, *GK, *GV, *QMEM, *KVM;
    __device__ __forceinline__ void operator()(const f32x4 (&acc)[2][2][4][2], const Unit& u, int wr, int wc, int fr, int fq) const {
        bf16_t* base; int ld, colt, nh = 2, rowb = u.pm * BM; const int pn = u.pn;
        if (pn < 6) { base = Q; ld = 1536; colt = pn * 256; }
        else if (pn == 6) { base = CKV; ld = 256; colt = 0; }
        else if (pn == 7) { base = KRAG; ld = 128; colt = 0; nh = 1; }
        else if (pn < 10) { base = GQ; ld = 512; colt = (pn - 8) * 256; }
        else if (pn < 12) { base = GK; ld = 512; colt = (pn - 10) * 256; }
        else if (pn < 16) { base = GV; ld = 1024; colt = (pn - 12) * 256; }
        else if (pn == 16) { base = QMEM; ld = 256; colt = 0; }
        else { base = KVM; ld = 1280; colt = (pn - 33) * 256; rowb = (u.pm - 64) * BM; }
        const int row0 = rowb + wr * 64 + fr, col0 = colt + wc * 32 + 8 * fq;
#pragma unroll
        for (int ai = 0; ai < 2; ++ai)
#pragma unroll
            for (int m = 0; m < 4; ++m) { bf16_t* rowp = base + (size_t)(row0 + ai * HALF + m * 16) * ld + col0;
#pragma unroll
                for (int bj = 0; bj < 2; ++bj) if (bj < nh) *(u32x4*)(rowp + bj * HALF) = pack8bf(acc[ai][bj][m][0], acc[ai][bj][m][1]); }
    }
};
struct EpiKvUp {
    static constexpr bool PERM = true, AFTER_DRAIN = false;
    const bf16_t* CKV; bf16_t *KN, *VM; const float* gk; PG8_LAS float* T; float eps;
    __device__ __forceinline__ void operator()(const f32x4 (&acc)[2][2][4][2], const Unit& u, int wr, int wc, int fr, int fq) const {
        typedef float f32x2v __attribute__((ext_vector_type(2)));
        PG8_LAS f32x2v* T2 = (PG8_LAS f32x2v*)T;
        asm volatile("" : "+v"(fr), "+v"(fq));
#pragma unroll
        for (int ai = 0; ai < 2; ++ai)
#pragma unroll
            for (int m = 0; m < 4; ++m) { const int rl = ai * HALF + wr * 64 + m * 16 + fr; const size_t row = (size_t)u.pm * BM + rl;
                const f32x4 a = acc[ai][0][m][0], b = acc[ai][0][m][1];
                float sy = (a[0] * a[0] + a[1] * a[1]) + (a[2] * a[2] + a[3] * a[3]) + (b[0] * b[0] + b[1] * b[1]) + (b[2] * b[2] + b[3] * b[3]);
                const u32x4* cp = (const u32x4*)(CKV + row * 256 + (wc * 4 + fq) * 16); f32x4 c0, c1, c2, c3; unpack8bf(cp[0], c0, c1); unpack8bf(cp[1], c2, c3);
                const f32x4 q = c0 * c0 + c1 * c1 + c2 * c2 + c3 * c3; float sc = (q[0] + q[1]) + (q[2] + q[3]);
                sy += __shfl_xor(sy, 16); sy += __shfl_xor(sy, 32); sc += __shfl_xor(sc, 16); sc += __shfl_xor(sc, 32);
                if (fq == 0) T2[rl * 4 + wc] = (f32x2v){sc, sy}; asm volatile("" ::: "memory"); }
        asm volatile("s_waitcnt lgkmcnt(0)" ::: "memory"); __builtin_amdgcn_s_barrier(); asm volatile("" ::: "memory");
        const int h = u.pn, col0 = h * 128 + wc * 32 + 8 * fq;
        const f32x4 g0 = *(const f32x4*)(gk + wc * 32 + 8 * fq), g1 = *(const f32x4*)(gk + wc * 32 + 8 * fq + 4);
#pragma unroll
        for (int ai = 0; ai < 2; ++ai)
#pragma unroll
            for (int m = 0; m < 4; ++m) { const int rl = ai * HALF + wr * 64 + m * 16 + fr; const size_t row = (size_t)u.pm * BM + rl;
                const f32x2v t0 = T2[rl * 4 + 0], t1 = T2[rl * 4 + 1], t2 = T2[rl * 4 + 2], t3 = T2[rl * 4 + 3];
                const float sc = (t0.x + t1.x) + (t2.x + t3.x), sy = (t0.y + t1.y) + (t2.y + t3.y);
                const float al = __builtin_amdgcn_rsqf(sc * (1.0f / 256.0f) + eps), kf = al * __builtin_amdgcn_rsqf(al * al * sy * (1.0f / 128.0f) + eps);
                *(u32x4*)(KN + row * 1024 + col0) = pack8bf(acc[ai][0][m][0] * kf * g0, acc[ai][0][m][1] * kf * g1);
                *(u32x4*)(VM + row * 1024 + col0) = pack8bf(acc[ai][1][m][0] * al, acc[ai][1][m][1] * al); asm volatile("" ::: "memory"); }
    }
};
struct EpiMerge {
    static constexpr bool PERM = true, AFTER_DRAIN = false;
    const float* bgate; bf16_t *QB, *GV, *OMEM, *Y;
    __device__ __forceinline__ void operator()(const f32x4 (&acc)[2][2][4][2], const Unit& u, int wr, int wc, int fr, int fq) const {
        const int sub = (u.pn - 17) >> 2, pny = (u.pn - 17) & 3;
        const int row0 = u.pm * BM + wr * 64 + fr;
#pragma unroll
        for (int bj = 0; bj < 2; ++bj) { const int cy = pny * 256 + bj * HALF + wc * 32 + 8 * fq;
            const int cq = (cy >> 7) * 192 + (cy & 127);
            f32x4 b0 = {0.f, 0.f, 0.f, 0.f}, b1 = b0;
            if (sub > 0) { b0 = *(const f32x4*)(bgate + (sub - 1) * 1024 + cy); b1 = *(const f32x4*)(bgate + (sub - 1) * 1024 + cy + 4); }
#pragma unroll
            for (int ai = 0; ai < 2; ++ai)
#pragma unroll
                for (int m = 0; m < 4; ++m) { const size_t row = (size_t)(row0 + ai * HALF + m * 16);
                    f32x4 v0 = acc[ai][bj][m][0] + b0, v1 = acc[ai][bj][m][1] + b1, s0, s1;
#pragma unroll
                    for (int i = 0; i < 4; ++i) { s0[i] = sigmoidf_(v0[i]); s1[i] = sigmoidf_(v1[i]); }
                    if (sub == 0) { s0 = s0 * v0; s1 = s1 * v1; }
                    f32x4 p0, p1;
                    if (sub == 0 || sub == 2) { u32x4* p = (u32x4*)(GV + row * 1024 + cy); unpack8bf(*p, p0, p1); *p = pack8bf(p0 * s0, p1 * s1); }
                    else if (sub == 1) { u32x4* p = (u32x4*)(QB + row * 1536 + cq); unpack8bf(*p, p0, p1); *p = pack8bf(p0 * s0, p1 * s1); }
                    else { f32x4 a0, a1, g0, g1; unpack8bf(*(const u32x4*)(OMEM + row * 1024 + cy), p0, p1); unpack8bf(*(const u32x4*)(QB + row * 1536 + cq), a0, a1); unpack8bf(*(const u32x4*)(GV + row * 1024 + cy), g0, g1);
                        *(u32x4*)(Y + row * 1024 + cy) = pack8bf(p0 * s0 + a0 + g0, p1 * s1 + a1 + g1); } } }
    }
};
struct EpiResF32 {
    static constexpr bool PERM = false, AFTER_DRAIN = false;
    const float* base; float* out; int ldc;
    __device__ __forceinline__ void operator()(const f32x4 (&acc)[2][2][4][2], const Unit& u, int wr, int wc, int fr, int fq) const {
        const int row0 = u.pm * BM + wr * 64 + fr, col0 = u.pn * BM + wc * 32 + 4 * fq;
#pragma unroll
        for (int ai = 0; ai < 2; ++ai)
#pragma unroll
            for (int m = 0; m < 4; ++m) { const size_t off = (size_t)(row0 + ai * HALF + m * 16) * ldc + col0;
#pragma unroll
                for (int bj = 0; bj < 2; ++bj)
#pragma unroll
                    for (int n = 0; n < 2; ++n) { const f32x4 bs = *(const f32x4*)(base + off + bj * HALF + n * 16); *(f32x4*)(out + off + bj * HALF + n * 16) = bs + acc[ai][bj][m][n]; } }
    }
};
struct EpiRelu2 {
    static constexpr bool PERM = true, AFTER_DRAIN = false;
    bf16_t* O; int ldc;
    __device__ __forceinline__ void operator()(const f32x4 (&acc)[2][2][4][2], const Unit& u, int wr, int wc, int fr, int fq) const {
        const int row0 = u.pm * BM + wr * 64 + fr, col0 = u.pn * BM + wc * 32 + 8 * fq;
#pragma unroll
        for (int ai = 0; ai < 2; ++ai)
#pragma unroll
            for (int m = 0; m < 4; ++m) { bf16_t* rowp = O + (size_t)(row0 + ai * HALF + m * 16) * ldc + col0;
#pragma unroll
                for (int bj = 0; bj < 2; ++bj) { f32x4 v0 = acc[ai][bj][m][0], v1 = acc[ai][bj][m][1];
#pragma unroll
                    for (int i = 0; i < 4; ++i) { const float a = fmaxf(v0[i], 0.f), b = fmaxf(v1[i], 0.f); v0[i] = a * a; v1[i] = b * b; }
                    *(u32x4*)(rowp + bj * HALF) = pack8bf(v0, v1); } }
    }
};
struct ProjOrder : StaticOrder {
    __device__ bool next(int i, Unit& u) const { const long L = (long)i * G + c; if (L < nwg) return StaticOrder::next(i, u); const int r = (int)(L - nwg); if (r >= 10) return false; u.pm = 64 + r / 5; u.pn = 33 + r % 5; return true; }
};
struct MergeOrder : StaticOrder {
    __device__ bool next(int i, Unit& u) const { if (i >= 4) return false; Unit t; if (!StaticOrder::next(0, t)) return false; u.pm = t.pm; u.pn = 17 + 4 * i + t.pn; return true; }
};
template <class Epi, class Sched, bool ALIGN_EPI = false, bool SP2 = false>
__device__ __forceinline__ void gemm_phase(PG8_LAS unsigned char* lds, const Gemm g, const Sched& S, const Epi& E) {
    const int tid = threadIdx.x, wid = __builtin_amdgcn_readfirstlane(tid >> 6), lane = tid & 63, wr = wid >> 2, wc = wid & 3, fr = lane & 15, fq = lane >> 4;
    const int K = g.K, nt = K / BK;
    unsigned voffA[2], voffB[2];
#pragma unroll
    for (int i = 0; i < 2; ++i) { int R, C; stage_rc(tid * 16 + i * 8192, R, C); const int Rb = Epi::PERM ? ((R & ~31) + perm32(R & 31)) : R;
        voffA[i] = (unsigned)(R * K + C) * 2u; voffB[i] = (unsigned)(Rb * K + C) * 2u; }
    const size_t kstep = (size_t)(BK * 2);
    const size_t hstep = (size_t)HALF * K * 2;
    const size_t tstep = 2 * hstep;
    const unsigned ldsw = (unsigned)wid * 1024u;
    const int aoff = lds_byte(wr * 64 + fr, fq * 8), boff = lds_byte(wc * 32 + fr, fq * 8);
#define PG8_SA(b, h) (((b) * 2 + (h)) * HTB)
#define PG8_SB(b, h) ((4 + (b) * 2 + (h)) * HTB)
#define PG8_STAGE(bufoff, gbase, voff) do { _Pragma("unroll") for (int _i = 0; _i < 2; ++_i) \
        __builtin_amdgcn_global_load_lds((const unsigned*)((const char*)(gbase) + (voff)[_i]), (PG8_LAS unsigned*)(lds + (bufoff) + ldsw + _i * 8192), 16, 0, 0); } while (0)
#define PG8_LDA(dst, b, h) do { _Pragma("unroll") for (int m = 0; m < 4; ++m) _Pragma("unroll") for (int k = 0; k < 2; ++k) dst[m][k] = *(const PG8_LAS bf16x8*)(lds + PG8_SA(b, h) + aoff + m * 2048 + k * 1024); } while (0)
#define PG8_LDB(dst, b, h) do { _Pragma("unroll") for (int n = 0; n < 2; ++n) _Pragma("unroll") for (int k = 0; k < 2; ++k) dst[n][k] = *(const PG8_LAS bf16x8*)(lds + PG8_SB(b, h) + boff + n * 2048 + k * 1024); } while (0)
#define PG8_MMA(ai, bj, At, Bt) do { __builtin_amdgcn_s_setprio(1); _Pragma("unroll") for (int m = 0; m < 4; ++m) _Pragma("unroll") for (int n = 0; n < 2; ++n) _Pragma("unroll") for (int k = 0; k < 2; ++k) \
        acc[ai][bj][m][n] = __builtin_amdgcn_mfma_f32_16x16x32_bf16(Bt[n][k], At[m][k], acc[ai][bj][m][n], 0, 0, 0); __builtin_amdgcn_s_setprio(0); } while (0)
#define PG8_WAIT_V(n) asm volatile("s_waitcnt vmcnt(" #n ")" ::: "memory")
#define PG8_WAIT_L(n) asm volatile("s_waitcnt lgkmcnt(" #n ")" ::: "memory")
#define PG8_BAR __builtin_amdgcn_s_barrier()
#define PG8_SCHED __builtin_amdgcn_sched_barrier(0)
    Unit cur, nxt; int ui = 0;
    if (!S.next(0, cur)) return;
    f32x4 acc[2][2][4][2];
#pragma unroll
    for (int a = 0; a < 2; ++a)
#pragma unroll
        for (int b = 0; b < 2; ++b)
#pragma unroll
            for (int m = 0; m < 4; ++m)
#pragma unroll
                for (int n = 0; n < 2; ++n) acc[a][b][m][n] = (f32x4){0.f, 0.f, 0.f, 0.f};
    bf16x8 At[4][2], B0[2][2], B1[2][2];
    const char* cA = (const char*)g.A + (size_t)cur.pm * tstep; const char* cB = (const char*)g.Bt + (size_t)cur.pn * tstep;
    S.a_ready(cur);
    if constexpr (SP2) {
        PG8_STAGE(PG8_SB(0, 0), cB, voffB); PG8_STAGE(PG8_SB(0, 1), cB + hstep, voffB); PG8_STAGE(PG8_SA(0, 0), cA, voffA); PG8_STAGE(PG8_SA(0, 1), cA + hstep, voffA);
        if (wr == 1) PG8_BAR;
        PG8_WAIT_V(2); PG8_BAR;
        PG8_STAGE(PG8_SB(1, 0), cB + kstep, voffB); PG8_STAGE(PG8_SA(1, 0), cA + kstep, voffA); PG8_STAGE(PG8_SB(1, 1), cB + hstep + kstep, voffB);
        PG8_WAIT_V(6); PG8_BAR;
    } else {
        PG8_STAGE(PG8_SB(0, 0), cB, voffB); PG8_STAGE(PG8_SA(0, 0), cA, voffA); PG8_STAGE(PG8_SB(0, 1), cB + hstep, voffB); PG8_STAGE(PG8_SA(0, 1), cA + hstep, voffA);
        if (wr == 1) PG8_BAR;
        PG8_WAIT_V(4); PG8_BAR;
        PG8_STAGE(PG8_SB(1, 0), cB + kstep, voffB); PG8_STAGE(PG8_SA(1, 0), cA + kstep, voffA); PG8_STAGE(PG8_SB(1, 1), cB + hstep + kstep, voffB);
        PG8_WAIT_V(6); PG8_BAR;
    }
    for (;;) {
        const bool has_next = S.next(ui + 1, nxt);
        const char* nA = has_next ? (const char*)g.A + (size_t)nxt.pm * tstep : cA; const char* nB = has_next ? (const char*)g.Bt + (size_t)nxt.pn * tstep : cB;
        for (int t = 0; t < nt; t += 2) {
            const bool last = (t == nt - 2);
            const char* a1 = cA + (size_t)(t + 1) * kstep;
            const char* a2 = last ? nA : cA + (size_t)(t + 2) * kstep; const char* b2 = last ? nB : cB + (size_t)(t + 2) * kstep;
            const char* a3 = a2 + kstep; const char* b3 = b2 + kstep;
            if (last && has_next) S.a_ready(nxt);
            if constexpr (SP2) {
            PG8_LDB(B0, 0, 0); PG8_LDB(B1, 0, 1); PG8_SCHED; PG8_LDA(At, 0, 0); PG8_STAGE(PG8_SA(1, 1), a1 + hstep, voffA);
            PG8_WAIT_V(8); PG8_WAIT_L(0); PG8_BAR; PG8_MMA(0, 0, At, B0); PG8_MMA(0, 1, At, B1); PG8_BAR; PG8_SCHED;
            PG8_LDA(At, 0, 1); PG8_STAGE(PG8_SB(0, 0), b2, voffB); PG8_STAGE(PG8_SB(0, 1), b2 + hstep, voffB); PG8_STAGE(PG8_SA(0, 0), a2, voffA);
            PG8_WAIT_V(8); PG8_WAIT_L(0); PG8_BAR; PG8_MMA(1, 0, At, B0); PG8_MMA(1, 1, At, B1); PG8_BAR; PG8_SCHED;
            PG8_LDB(B0, 1, 0); PG8_LDB(B1, 1, 1); PG8_SCHED; PG8_LDA(At, 1, 0); PG8_STAGE(PG8_SA(0, 1), a2 + hstep, voffA);
            PG8_WAIT_V(8); PG8_WAIT_L(0); PG8_BAR; PG8_MMA(0, 0, At, B0); PG8_MMA(0, 1, At, B1); PG8_BAR; PG8_SCHED;
            PG8_LDA(At, 1, 1); PG8_STAGE(PG8_SB(1, 0), b3, voffB); PG8_STAGE(PG8_SB(1, 1), b3 + hstep, voffB); PG8_STAGE(PG8_SA(1, 0), a3, voffA);
            PG8_WAIT_V(8); PG8_WAIT_L(0); PG8_BAR; PG8_MMA(1, 0, At, B0); PG8_MMA(1, 1, At, B1); PG8_BAR; PG8_SCHED;
            } else {
            PG8_LDB(B0, 0, 0); PG8_SCHED; PG8_LDA(At, 0, 0); PG8_STAGE(PG8_SA(1, 1), a1 + hstep, voffA);
            PG8_WAIT_L(8); PG8_BAR; PG8_WAIT_L(0); PG8_MMA(0, 0, At, B0); PG8_BAR; PG8_SCHED;
            PG8_LDB(B1, 0, 1); PG8_STAGE(PG8_SB(0, 0), b2, voffB);
            PG8_BAR; PG8_WAIT_L(0); PG8_MMA(0, 1, At, B1); PG8_BAR;
            PG8_LDA(At, 0, 1); PG8_STAGE(PG8_SA(0, 0), a2, voffA);
            PG8_BAR; PG8_WAIT_L(0); PG8_MMA(1, 0, At, B0); PG8_BAR; PG8_SCHED;
            PG8_STAGE(PG8_SB(0, 1), b2 + hstep, voffB);
            PG8_WAIT_V(6); PG8_BAR; PG8_MMA(1, 1, At, B1); PG8_BAR;
            PG8_LDB(B0, 1, 0); PG8_SCHED; PG8_LDA(At, 1, 0); PG8_STAGE(PG8_SA(0, 1), a2 + hstep, voffA);
            PG8_WAIT_L(8); PG8_BAR; PG8_WAIT_L(0); PG8_MMA(0, 0, At, B0); PG8_BAR; PG8_SCHED;
            PG8_LDB(B1, 1, 1); PG8_STAGE(PG8_SB(1, 0), b3, voffB);
            PG8_BAR; PG8_WAIT_L(0); PG8_MMA(0, 1, At, B1); PG8_BAR;
            PG8_LDA(At, 1, 1); PG8_STAGE(PG8_SA(1, 0), a3, voffA);
            PG8_BAR; PG8_WAIT_L(0); PG8_MMA(1, 0, At, B0); PG8_BAR; PG8_SCHED;
            PG8_STAGE(PG8_SB(1, 1), b3 + hstep, voffB);
            PG8_WAIT_V(6); PG8_BAR; PG8_MMA(1, 1, At, B1); PG8_BAR;
            }
        }
        if constexpr (ALIGN_EPI) { if (wr == 0) PG8_BAR; }
        if constexpr (!Epi::AFTER_DRAIN) { E(acc, cur, wr, wc, fr, fq); S.done(cur); }
        if (!has_next) break;
#pragma unroll
        for (int a = 0; a < 2; ++a)
#pragma unroll
            for (int b = 0; b < 2; ++b)
#pragma unroll
                for (int m = 0; m < 4; ++m)
#pragma unroll
                    for (int n = 0; n < 2; ++n) acc[a][b][m][n] = (f32x4){0.f, 0.f, 0.f, 0.f};
        cur = nxt; cA = nA; cB = nB; ++ui;
        if constexpr (ALIGN_EPI) { if (wr == 1) PG8_BAR; }
    }
    PG8_WAIT_V(0);
    if constexpr (!ALIGN_EPI) { if (wr == 0) PG8_BAR; }
    PG8_BAR;
    if constexpr (Epi::AFTER_DRAIN) { E.fused(acc, cur, wr, wc, fr, fq, lds, wid, lane); S.done(cur); }
#undef PG8_SA
#undef PG8_SB
#undef PG8_STAGE
#undef PG8_LDA
#undef PG8_LDB
#undef PG8_MMA
#undef PG8_WAIT_V
#undef PG8_WAIT_L
#undef PG8_BAR
#undef PG8_SCHED
}
}
namespace att {
typedef short bf16x8 __attribute__((ext_vector_type(8)));
typedef short s16x4 __attribute__((ext_vector_type(4)));
typedef float f32x16 __attribute__((ext_vector_type(16)));
typedef float f32x4 __attribute__((ext_vector_type(4)));
typedef unsigned u32x4 __attribute__((ext_vector_type(4)));
#define ATT_SBAR() __builtin_amdgcn_sched_barrier(0)
__device__ __forceinline__ int v_st(int k, int c) { const int kk = (k & ~0xC) | ((k & 4) << 1) | ((k & 8) >> 1); return ((kk >> 3) * 4 + (c >> 5)) * 512 + ((kk & 7) * 32 + (c & 31)) * 2; }
__device__ __forceinline__ int v_rd_base(int lane) { return ((lane & 3) << 3) | (((lane >> 2) & 3) << 6) | (((lane >> 4) & 1) << 5) | (((lane >> 5) & 1) << 8); }
constexpr int v_rd_off(int d0, int ks, int half) { return d0 * 512 + ks * 4096 + half * 2048; }
__device__ __forceinline__ int crow(int r, int hi) { return (r & 3) + 8 * (r >> 2) + 4 * hi; }
__device__ __forceinline__ unsigned cvtpk(float lo, float hi) { unsigned r; asm volatile("v_cvt_pk_bf16_f32 %0, %1, %2" : "=v"(r) : "v"(lo), "v"(hi)); return r; }
__device__ __forceinline__ bf16x8 pack8(f32x4 a, f32x4 b) { u32x4 w = {cvtpk(a[0], a[1]), cvtpk(a[2], a[3]), cvtpk(b[0], b[1]), cvtpk(b[2], b[3])}; return __builtin_bit_cast(bf16x8, w); }
constexpr float THRL = 8.0f;
__device__ __forceinline__ void mask_tile(f32x16& p0, f32x16& p1, int dq) {
    const float NEG = -__builtin_inff();
#pragma unroll
    for (int r = 0; r < 16; ++r) { const int c = (r & 3) + 8 * (r >> 2); if (dq - c < 0) p0[r] = NEG; if (dq - c - 32 < 0) p1[r] = NEG; }
}
__device__ __forceinline__ void softmax_tile(f32x16& p0, f32x16& p1, float& m_reg, float& l_reg, float& alpha, bf16x8& pa0, bf16x8& pa1, bf16x8& pa2, bf16x8& pa3) {
    float pmax = p0[0];
#pragma unroll
    for (int r = 1; r < 16; ++r) pmax = fmaxf(pmax, p0[r]);
#pragma unroll
    for (int r = 0; r < 16; ++r) pmax = fmaxf(pmax, p1[r]);
    { auto rr = __builtin_amdgcn_permlane32_swap(__float_as_uint(pmax), __float_as_uint(pmax), false, false); pmax = fmaxf(__uint_as_float(rr[0]), __uint_as_float(rr[1])); }
    float mn;
    if (__builtin_expect(__all(pmax - m_reg <= THRL), 1)) { mn = m_reg; alpha = 1.f; }
    else { mn = fmaxf(m_reg, pmax); alpha = __builtin_amdgcn_exp2f(m_reg - mn); m_reg = mn; }
#pragma unroll
    for (int r = 0; r < 16; ++r) { p0[r] = __builtin_amdgcn_exp2f(p0[r] - mn); p1[r] = __builtin_amdgcn_exp2f(p1[r] - mn); }
    float ps = 0.f;
#pragma unroll
    for (int r = 0; r < 16; ++r) ps += p0[r];
#pragma unroll
    for (int r = 0; r < 16; ++r) ps += p1[r];
    { auto rr = __builtin_amdgcn_permlane32_swap(__float_as_uint(ps), __float_as_uint(ps), false, false); ps = __uint_as_float(rr[0]) + __uint_as_float(rr[1]); }
    l_reg = l_reg * alpha + ps;
#define ATT_PK4(P, B_, OUT) do { unsigned a0 = cvtpk(P[B_+0], P[B_+1]), a1 = cvtpk(P[B_+2], P[B_+3]); unsigned b0 = cvtpk(P[B_+4], P[B_+5]), b1 = cvtpk(P[B_+6], P[B_+7]); \
        auto r0 = __builtin_amdgcn_permlane32_swap(a0, b0, false, false); auto r1 = __builtin_amdgcn_permlane32_swap(a1, b1, false, false); \
        u32x4 w = {r0[0], r1[0], r0[1], r1[1]}; OUT = __builtin_bit_cast(bf16x8, w); } while (0)
    ATT_PK4(p0, 0, pa0); ATT_PK4(p0, 8, pa1); ATT_PK4(p1, 0, pa2); ATT_PK4(p1, 8, pa3);
#undef ATT_PK4
}
template <int DQK> __device__ __forceinline__ void qkt(f32x16& p0, f32x16& p1, const PG8_LAS char* Kb, int r32, int hi, const bf16x8* qr) {
    constexpr int KSTR = DQK * 2 + 16;
    p0 = f32x16{}; p1 = f32x16{};
    const PG8_LAS char* a = Kb + r32 * KSTR + hi * 16;
#pragma unroll
    for (int d0 = 0; d0 < DQK / 16; ++d0) {
        const bf16x8 b0 = *(const PG8_LAS bf16x8*)(a + d0 * 32), b1 = *(const PG8_LAS bf16x8*)(a + d0 * 32 + 32 * KSTR);
        p0 = __builtin_amdgcn_mfma_f32_32x32x16_bf16(b0, qr[d0], p0, 0, 0, 0);
        p1 = __builtin_amdgcn_mfma_f32_32x32x16_bf16(b1, qr[d0], p1, 0, 0, 0); }
}
__device__ __forceinline__ void pv_block(f32x16* o, int vb0, bf16x8 pa0, bf16x8 pa1, bf16x8 pa2, bf16x8 pa3) {
#define ATT_TRRD(dst, off) asm volatile("ds_read_b64_tr_b16 %0, %1 offset:%2" : "=&v"(dst) : "v"(vb0), "i"(off) : "memory")
#define ATT_PV_D0(d0) do { s16x4 l0, l1, l2, l3, h0, h1, h2, h3; constexpr int b_ = v_rd_off(d0, 0, 0); \
        ATT_TRRD(l0, b_); ATT_TRRD(h0, b_ + 2048); ATT_TRRD(l1, b_ + 4096); ATT_TRRD(h1, b_ + 6144); ATT_TRRD(l2, b_ + 8192); ATT_TRRD(h2, b_ + 10240); ATT_TRRD(l3, b_ + 12288); ATT_TRRD(h3, b_ + 14336); \
        asm volatile("s_waitcnt lgkmcnt(0)" ::: "memory"); ATT_SBAR(); \
        o[d0] = __builtin_amdgcn_mfma_f32_32x32x16_bf16(pa0, (bf16x8){l0[0], l0[1], l0[2], l0[3], h0[0], h0[1], h0[2], h0[3]}, o[d0], 0, 0, 0); \
        o[d0] = __builtin_amdgcn_mfma_f32_32x32x16_bf16(pa1, (bf16x8){l1[0], l1[1], l1[2], l1[3], h1[0], h1[1], h1[2], h1[3]}, o[d0], 0, 0, 0); \
        o[d0] = __builtin_amdgcn_mfma_f32_32x32x16_bf16(pa2, (bf16x8){l2[0], l2[1], l2[2], l2[3], h2[0], h2[1], h2[2], h2[3]}, o[d0], 0, 0, 0); \
        o[d0] = __builtin_amdgcn_mfma_f32_32x32x16_bf16(pa3, (bf16x8){l3[0], l3[1], l3[2], l3[3], h3[0], h3[1], h3[2], h3[3]}, o[d0], 0, 0, 0); } while (0)
    ATT_PV_D0(0); ATT_PV_D0(1); ATT_PV_D0(2); ATT_PV_D0(3);
#undef ATT_PV_D0
#undef ATT_TRRD
}
template <int DQK, int DV, bool CAUSAL, bool PREF, class Src>
__device__ __forceinline__ void attn_unit(PG8_LAS char* lds, const bf16x8* qr, const int NT, const int qrel  , const Src& S) {
    constexpr int KSTR = DQK * 2 + 16, KT = 64 * KSTR, NVB = DV / 128, VT = NVB * 16384, NKC = DQK / 64, NVC = NVB * 2;
    constexpr int OFF_K = 0, OFF_V = 2 * KT, OFF_WS = 2 * KT + 2 * VT;
    const int tid = threadIdx.x, wid = __builtin_amdgcn_readfirstlane(tid >> 6), lane = tid & 63, r32 = lane & 31, hi = lane >> 5;
    PG8_LAS float* al_l = (PG8_LAS float*)(lds + OFF_WS) + wid * 64; PG8_LAS float* li_l = al_l + 32;
    const int vb0 = (int)(unsigned)(uintptr_t)(lds + OFF_V) + v_rd_base(lane);
    float m_reg = -1e30f, l_reg = 0.f; f32x16 o[NVB * 4];
#pragma unroll
    for (int i = 0; i < NVB * 4; ++i) o[i] = f32x16{};
    u32x4 sk[NKC], sv[NVC];
#define ATT_WRITE(bf) S.write(lds + OFF_K + (bf) * KT, lds + OFF_V + (bf) * VT, sk, sv)
    S.load(0, sk, sv); ATT_WRITE(0);
    __syncthreads();
#define ATT_STEP(BUF, t) do { \
        if (PREF && (t) + 1 < NT) S.load((t) + 1, sk, sv); \
        f32x16 p0, p1; float alpha; bf16x8 pa0, pa1, pa2, pa3; \
        ATT_SBAR(); qkt<DQK>(p0, p1, lds + OFF_K + (BUF) * KT, r32, hi, qr); \
        if (CAUSAL && (t) >= NT - 4) { const int jb = (t) - (NT - 4); if (64 * jb + 63 > qrel) mask_tile(p0, p1, qrel + r32 - 4 * hi - 64 * jb); } \
        softmax_tile(p0, p1, m_reg, l_reg, alpha, pa0, pa1, pa2, pa3); \
        if (__any(alpha < 1.f)) { if (hi == 0) al_l[r32] = alpha; asm volatile("s_waitcnt lgkmcnt(0)" ::: "memory"); \
            _Pragma("unroll") for (int d_ = 0; d_ < NVB * 4; ++d_) _Pragma("unroll") for (int r = 0; r < 16; ++r) o[d_][r] *= al_l[crow(r, hi)]; } \
        ATT_SBAR(); \
        _Pragma("unroll") for (int vb = 0; vb < NVB; ++vb) pv_block(o + 4 * vb, vb0 + (BUF) * VT + vb * 16384, pa0, pa1, pa2, pa3); \
        if ((t) + 1 < NT) { if (!PREF) S.load((t) + 1, sk, sv); ATT_WRITE((BUF) ^ 1); } \
        __syncthreads(); } while (0)
    for (int t = 0; t < NT; t += 2) { ATT_STEP(0, t); ATT_STEP(1, t + 1); }
#undef ATT_STEP
#undef ATT_WRITE
    if (hi == 0) li_l[r32] = l_reg;
    asm volatile("s_waitcnt lgkmcnt(0)" ::: "memory");
#pragma unroll
    for (int r = 0; r < 16; ++r) { const float rl = __builtin_amdgcn_rcpf(li_l[crow(r, hi)]); const int orow = crow(r, hi);
#pragma unroll
        for (int d = 0; d < NVB * 4; ++d) { const float v = o[d][r] * rl; const float vn = __shfl_xor(v, 1); if ((r32 & 1) == 0) S.store(orow, d * 32 + r32, v, vn); } }
    __syncthreads();
}
#undef ATT_SBAR
}
constexpr int NWAVES = 8;
#ifndef MK_N_LAUNCHES
#define MK_N_LAUNCHES 1
#endif
constexpr int PER_PHASE = 10;
constexpr int N_LAUNCHES = MK_N_LAUNCHES;

constexpr int BATCH = 2, SEQ = 8192, D = 1024, M = BATCH * SEQ, MEM_LEN = 256, MROWS = BATCH * MEM_LEN;
constexpr int D_IN = 8272, FF = 4096;
constexpr int NP1 = 17 * 256;
constexpr int NPAD = 33 * 256;
constexpr float EPS = 1e-6f;
constexpr float QK_SCALE_L2 = 0.07216878364870322f * 1.4426950408889634f;
constexpr float MEM_SCALE_L2 = 0.125f * 1.4426950408889634f;
constexpr int GC = 128, GNC = SEQ / GC;

constexpr size_t MiB = 1u << 20;
constexpr size_t WS_CTL = 0, CTL_ZERO_BYTES = 1 * MiB;
constexpr size_t WS_WIN = 1 * MiB;
constexpr size_t WS_WUKV = 20 * MiB;
constexpr size_t WS_WO = 21 * MiB;
constexpr size_t WS_WUP = 23 * MiB;
constexpr size_t WS_WDN = 31 * MiB;
constexpr size_t WS_XN = 39 * MiB;
constexpr size_t WS_Q = 72 * MiB;
constexpr size_t WS_GQ = 120 * MiB, WS_GK = 136 * MiB, WS_GV = 152 * MiB;
constexpr size_t WS_CKV = 184 * MiB, WS_QMEM = 192 * MiB, WS_KRAG = 200 * MiB, WS_KVM = 204 * MiB;
constexpr size_t WS_ST = 206 * MiB;
constexpr size_t WS_KPE = 238 * MiB;
constexpr size_t WS_ROPE = 240 * MiB;
constexpr size_t WS_DEC = 244 * MiB;
constexpr size_t WS_H = 72 * MiB;
constexpr size_t WS_END = 256 * MiB;
constexpr int CW_TMO = 0, CW_CODE = 1, CW_BAR = 4096;

constexpr int RING_OFF = 0, RING_BYTES = 131072;
constexpr int PHASE_BYTES = 139264;
constexpr int EXCH_OFF = 139264;
constexpr int LDSCTL_OFF = 147456, MISC_OFF = LDSCTL_OFF + 320;
constexpr int LDS_BYTES = 148480;

#define GAS __attribute__((address_space(1)))
#define LAS __attribute__((address_space(3)))
typedef unsigned short bf16;
typedef unsigned v4u __attribute__((ext_vector_type(4)));
typedef float f32x4 __attribute__((ext_vector_type(4)));
typedef short bf16x8 __attribute__((ext_vector_type(8)));
typedef GAS unsigned gu32;
typedef GAS unsigned long long gu64;
#define RLX_AGENT __ATOMIC_RELAXED, __HIP_MEMORY_SCOPE_AGENT
#define LDS_WAIT() asm volatile("s_waitcnt lgkmcnt(0)" ::: "memory")
#define VM_WAIT() asm volatile("s_waitcnt vmcnt(0)" ::: "memory")
__device__ __forceinline__ unsigned long long rt() { return __builtin_amdgcn_s_memrealtime(); }
__device__ __forceinline__ unsigned f2bf(float f) { unsigned u = __builtin_bit_cast(unsigned, f); return (u + 0x7fffu + ((u >> 16) & 1u)) >> 16; }
__device__ __forceinline__ unsigned pk2(float lo, float hi) { return f2bf(lo) | (f2bf(hi) << 16); }
#define XB_TMO      128
#define XB_XCNT(j)  (256  + 64 * (j))
#define XB_XSUB(j)  (1280 + 64 * (j))
#define XB_XGEN(j)  (2304 + 64 * (j))
#define XB_TOP      3328
#define XB_TOPGEN   3392
#define XCD_BAR_WORDS 3456
#define XB_SPIN_CAP (1u << 18)

__device__ __forceinline__ unsigned xb_ld(unsigned* p)              { return __hip_atomic_load(p, __ATOMIC_RELAXED, __HIP_MEMORY_SCOPE_AGENT); }
__device__ __forceinline__ unsigned xb_add(unsigned* p, unsigned v) { return __hip_atomic_fetch_add(p, v, __ATOMIC_RELAXED, __HIP_MEMORY_SCOPE_AGENT); }
__device__ __forceinline__ unsigned xb_xcc_id() { return (unsigned)__builtin_amdgcn_s_getreg((3 << 11) | 20) & 0xFu; }
#define XB_SPIN(cond, bar) do { unsigned _sp = 0; while (cond) { __builtin_amdgcn_s_sleep(1); \
    if ((++_sp & 255u) == 0u) { if (xb_ld(&(bar)[XB_TMO])) break; if (_sp > XB_SPIN_CAP) { atomicAdd(&(bar)[XB_TMO], 1u); break; } } } } while (0)

struct XcdBarrier {
    unsigned* bar; unsigned x;
    volatile LAS unsigned* st;
};

__device__ __forceinline__ XcdBarrier xcd_barrier_post(unsigned* bar, volatile LAS unsigned* st) {
    XcdBarrier b; b.bar = bar; b.x = xb_xcc_id(); b.st = st;
    if (threadIdx.x == 0) (void)xb_add(&bar[XB_XCNT(b.x)], 1u);
    return b;
}
__device__ __forceinline__ void xcd_barrier_complete(unsigned* bar, unsigned x, unsigned& nloc, unsigned& nx) {
    const unsigned G = gridDim.x * gridDim.y * gridDim.z;
    unsigned sum, cnt, mine, sp = 0u;
    for (;;) {
        sum = 0u; cnt = 0u; mine = 0u;
#pragma unroll
        for (unsigned j = 0; j < 16; ++j) { const unsigned c = xb_ld(&bar[XB_XCNT(j)]); sum += c; cnt += (c > 0u) ? 1u : 0u; mine = (j == x) ? c : mine; }
        if (sum == G) break;
        __builtin_amdgcn_s_sleep(1);
        if ((++sp & 255u) == 0u) { if (xb_ld(&bar[XB_TMO])) break; if (sp > XB_SPIN_CAP) { atomicAdd(&bar[XB_TMO], 1u); break; } }
    }
    nloc = mine > 0u ? mine : 1u; nx = cnt > 0u ? cnt : 1u;
}

__device__ __forceinline__ void xcd_barrier(const XcdBarrier& b) {
    asm volatile("s_waitcnt vmcnt(0)" ::: "memory");
    __syncthreads();
    if (threadIdx.x == 0) {
        unsigned* bar = b.bar;
        __builtin_amdgcn_s_waitcnt(0);
        unsigned nloc = b.st[0], nx = b.st[1];
        if (nloc == 0u) { xcd_barrier_complete(bar, b.x, nloc, nx); b.st[0] = nloc; b.st[1] = nx; }
        const unsigned old = xb_add(&bar[XB_XSUB(b.x)], 1u);
        const unsigned gen = old / nloc;
        if (old + 1u == (gen + 1u) * nloc) {
            __builtin_amdgcn_fence(__ATOMIC_RELEASE, "agent");
            asm volatile("s_waitcnt vmcnt(0)" ::: "memory");
            const unsigned og = xb_add(&bar[XB_TOP], 1u);
            const unsigned tg = og / nx;
            if (og + 1u == (tg + 1u) * nx) xb_add(&bar[XB_TOPGEN], 1u);
            else XB_SPIN(xb_ld(&bar[XB_TOPGEN]) == tg, bar);
            __builtin_amdgcn_fence(__ATOMIC_ACQUIRE, "agent");
            xb_add(&bar[XB_XGEN(b.x)], 1u);
            asm volatile("s_waitcnt vmcnt(0)" ::: "memory");
        } else {
            XB_SPIN(xb_ld(&bar[XB_XGEN(b.x)]) == gen, bar);
            __builtin_amdgcn_fence(__ATOMIC_ACQUIRE, "agent");
            asm volatile("s_waitcnt vmcnt(0)" ::: "memory");
        }
    }
    __syncthreads();
}

struct Frame {
    LAS unsigned char* lds;
    volatile LAS unsigned* MISC;
    gu32* ctl;
    int tid, lane, wave;
    int vcu, G;
    unsigned char* ws; float* out;
};
#define WSP(T, off) ((T*)(F.ws + (off)))

__device__ __forceinline__ float wave_sum(float v) {
#pragma unroll
    for (int o = 1; o < 64; o <<= 1) v += __shfl_xor(v, o);
    return v;
}
__device__ __forceinline__ void tr_item(const float* W, int ldw, int K, int col0, int ncols, bf16* WT, int row_off, LAS float* scr, int item, int lane, const float* kscale, float cscale) {
    const int nblk = (ncols + 31) / 32, kb = item / nblk, nb = item % nblk, k0 = 64 * kb, n0 = 32 * nb;
    const bool cv = (n0 + (lane & 31)) < ncols;
#pragma unroll 8
    for (int i = 0; i < 32; ++i) { const int kk = 2 * i + (lane >> 5); float v = cv ? W[(size_t)(k0 + kk) * ldw + col0 + n0 + (lane & 31)] : 0.f; v *= cscale; if (kscale) v *= kscale[k0 + kk]; scr[kk * 33 + (lane & 31)] = v; }
    LDS_WAIT(); asm volatile("" ::: "memory");
    const int c = lane & 7;
#pragma unroll
    for (int j = 0; j < 4; ++j) { const int n = (lane >> 3) + 8 * j; const LAS float* s = scr + (8 * c) * 33 + n;
        v4u o; o.x = pk2(s[0 * 33], s[1 * 33]); o.y = pk2(s[2 * 33], s[3 * 33]); o.z = pk2(s[4 * 33], s[5 * 33]); o.w = pk2(s[6 * 33], s[7 * 33]);
        *(GAS v4u*)(WT + (size_t)(row_off + n0 + n) * K + k0 + 8 * c) = o; }
    LDS_WAIT(); asm volatile("" ::: "memory");
}
__device__ __forceinline__ void rms_row_to_bf16(int lane, const float* xrow, const float* g, bf16* orow) {
    const GAS f32x4* xr = (const GAS f32x4*)xrow + lane; const GAS f32x4* gr = (const GAS f32x4*)g + lane;
    f32x4 v[4]; float s = 0.f;
#pragma unroll
    for (int j = 0; j < 4; ++j) { v[j] = xr[64 * j]; s += (v[j].x * v[j].x + v[j].y * v[j].y) + (v[j].z * v[j].z + v[j].w * v[j].w); }
    const float rstd = 1.f / sqrtf(wave_sum(s) * (1.f / D) + EPS);
    GAS unsigned long long* o8 = (GAS unsigned long long*)orow + lane;
#pragma unroll
    for (int j = 0; j < 4; ++j) { const f32x4 gg = gr[64 * j]; o8[64 * j] = (unsigned long long)pk2(v[j].x * rstd * gg.x, v[j].y * rstd * gg.y) | ((unsigned long long)pk2(v[j].z * rstd * gg.z, v[j].w * rstd * gg.w) << 32); }
}
struct RopeArg { double inv_rev[32]; };
struct P0In { const float *x, *mem; const int* pos; const float *g_mix, *w_in, *g_ckv, *w_ukv, *g_mem, *w_mem_kv, *w_o, *w_up, *w_down; };
__device__ __forceinline__ void p0_prologue(Frame& F, const P0In& I, const RopeArg& ra) {
    LAS float* scr = (LAS float*)(F.lds + RING_OFF + F.wave * 16384);
    const int gw = F.vcu * NWAVES + F.wave, NGW = F.G * NWAVES;
    bf16* Win_t = WSP(bf16, WS_WIN);
    {
#define SEG(W_, ldw_, K_, col0_, ncols_, WT_, roff_, ks_, cs_) { const int n_ = ((K_) / 64) * (((ncols_) + 31) / 32); if (r < n_) { tr_item(W_, ldw_, K_, col0_, ncols_, WT_, roff_, scr, r, F.lane, ks_, cs_); continue; } r -= n_; }
        constexpr int NIT = 16 * (48 + 8 + 2 + 1 + 16 + 16 + 32 + 8 + 32 + 96) + 16 * 40 + 4 * 64 + 16 * 32 + 16 * 128 + 64 * 32;
        for (int it = gw; it < NIT; it += NGW) { int r = it;
            SEG(I.w_in, D_IN, 1024, 0, 1536, Win_t, 0, nullptr, 1.f)
            SEG(I.w_in, D_IN, 1024, 1536, 256, Win_t, 1536, nullptr, 1.f)
            SEG(I.w_in, D_IN, 1024, 1792, 64, Win_t, 1792, nullptr, 1.f)
            SEG(I.w_in, D_IN, 1024, 3904, 16, Win_t, 1856, nullptr, 1.f)
            SEG(I.w_in, D_IN, 1024, 1856, 512, Win_t, 2048, nullptr, 0.08838834764831845f)
            SEG(I.w_in, D_IN, 1024, 2368, 512, Win_t, 2560, nullptr, 1.f)
            SEG(I.w_in, D_IN, 1024, 2880, 1024, Win_t, 3072, nullptr, 1.f)
            SEG(I.w_in, D_IN, 1024, 4944, 256, Win_t, 4096, nullptr, 1.f)
            SEG(I.w_in, D_IN, 1024, 3920, 1024, Win_t, 4352, nullptr, 1.f)
            SEG(I.w_in, D_IN, 1024, 5200, 3072, Win_t, 5376, nullptr, 1.f)
            SEG(I.w_mem_kv, 1280, 1024, 0, 1280, Win_t, NPAD, nullptr, 1.f)
            SEG(I.w_ukv, 2048, 256, 0, 2048, WSP(bf16, WS_WUKV), 0, I.g_ckv, 1.f)
            SEG(I.w_o, 1024, 1024, 0, 1024, WSP(bf16, WS_WO), 0, nullptr, 1.f)
            SEG(I.w_up, 4096, 1024, 0, 4096, WSP(bf16, WS_WUP), 0, nullptr, 1.f)
            SEG(I.w_down, 1024, 4096, 0, 1024, WSP(bf16, WS_WDN), 0, nullptr, 1.f)
        }
#undef SEG
    }
    { const int gt = F.vcu * 512 + F.tid, NGT = F.G * 512; v4u z = {0u, 0u, 0u, 0u};
      for (int i = gt; i < 160 * 128; i += NGT) *(GAS v4u*)(Win_t + (size_t)1888 * 1024 + (size_t)i * 8) = z; }
    bf16* XN = WSP(bf16, WS_XN);
    for (int m = gw; m < M + MROWS; m += NGW) { if (m < M) rms_row_to_bf16(F.lane, I.x + (size_t)m * D, I.g_mix, XN + (size_t)m * D); else rms_row_to_bf16(F.lane, I.mem + (size_t)(m - M) * D, I.g_mem, XN + (size_t)m * D); }
    { float* COS = WSP(float, WS_ROPE); float* SIN = COS + (size_t)M * 32; const int gt = F.vcu * 512 + F.tid, NGT = F.G * 512;
      for (int i = gt; i < M * 32; i += NGT) { const int m = i >> 5, k = i & 31; const double rev = (double)I.pos[m] * ra.inv_rev[k]; const float fr = (float)(rev - floor(rev));
          COS[i] = __builtin_amdgcn_cosf(fr); SIN[i] = __builtin_amdgcn_sinf(fr); } }
}

__device__ __forceinline__ void kpe_phase(Frame& F, const float* g_k_rope) {
    const bf16* KRAG = WSP(bf16, WS_KRAG); bf16* KPE = WSP(bf16, WS_KPE); const float* COS = WSP(float, WS_ROPE); const float* SIN = COS + (size_t)M * 32;
    const int hw = (F.vcu * 512 + F.tid) >> 5, NHW = F.G * 16, i = F.tid & 31;
    const float g1 = g_k_rope[i], g2 = g_k_rope[i + 32];
    for (int m = hw; m < M; m += NHW) {
        const float t1 = __uint_as_float((unsigned)KRAG[(size_t)m * 128 + i] << 16), t2 = __uint_as_float((unsigned)KRAG[(size_t)m * 128 + 32 + i] << 16);
        float s = t1 * t1 + t2 * t2;
#pragma unroll
        for (int o = 1; o < 32; o <<= 1) s += __shfl_xor(s, o);
        const float rs = __builtin_amdgcn_rsqf(s * (1.f / 64.f) + EPS), a = t1 * rs * g1, b = t2 * rs * g2, c = COS[(size_t)m * 32 + i], sn = SIN[(size_t)m * 32 + i];
        KPE[(size_t)m * 64 + i] = (bf16)f2bf(a * c - b * sn); KPE[(size_t)m * 64 + 32 + i] = (bf16)f2bf(a * sn + b * c);
    }
}

typedef float f32x16 __attribute__((ext_vector_type(16)));
constexpr int GSTR = 272;
__device__ __forceinline__ int crow_(int r, int hi) { return (r & 3) + 8 * (r >> 2) + 4 * hi; }
__device__ __forceinline__ void mm32(f32x16& acc, const LAS unsigned char* X, const LAS unsigned char* Y, int r32, int hi, int ks0, int ks1) {
    const LAS unsigned char* xa = X + r32 * GSTR + hi * 16; const LAS unsigned char* ya = Y + r32 * GSTR + hi * 16;
    for (int ks = ks0; ks < ks1; ++ks) { const bf16x8 a = *(const LAS bf16x8*)(xa + ks * 32), b = *(const LAS bf16x8*)(ya + ks * 32); acc = __builtin_amdgcn_mfma_f32_32x32x16_bf16(a, b, acc, 0, 0, 0); }
}
__device__ __forceinline__ float log_sigmoid_(float z) { return fminf(z, 0.f) - __logf(1.f + __expf(-fabsf(z))); }
__device__ __forceinline__ void gla_local_unit(Frame& F, int unit, const float* w_gla_gate, const float* b_gla_gate) {
    const int tid = F.tid, lane = F.lane, wave = F.wave, r32 = lane & 31, hi = lane >> 5;
    const int bh = unit / GNC, c = unit % GNC, b = bh >> 2, h = bh & 3; const size_t tok0 = (size_t)b * SEQ + (size_t)c * GC;
    LAS unsigned char* lds = F.lds;
    LAS float* BL = (LAS float*)lds;
    LAS unsigned char* VT = lds;
    LAS unsigned char* KT = lds + 69632;
    LAS float* AL = (LAS float*)(lds + 104448);
    LAS float* DECL = (LAS float*)(lds + 112640);
    LAS float* QT = (LAS float*)(lds + 113152);
    const bf16* KRAG = WSP(bf16, WS_KRAG); bf16* GQ = WSP(bf16, WS_GQ); bf16* GK = WSP(bf16, WS_GK); const bf16* GV = WSP(bf16, WS_GV);
    if (tid < 256) { const int t = tid >> 1, hf = tid & 1; const v4u w = *(const GAS v4u*)(KRAG + (tok0 + t) * 128 + 64 + hf * 8); f32x4 a0, a1; pg8::unpack8bf(w, a0, a1);
        *(LAS f32x4*)(AL + t * 16 + hf * 8) = a0; *(LAS f32x4*)(AL + t * 16 + hf * 8 + 4) = a1; }
    __syncthreads();
    { const int d = tid & 127, tq = tid >> 7; float w[16];
#pragma unroll
      for (int k = 0; k < 16; ++k) w[k] = w_gla_gate[k * 512 + h * 128 + d];
      const float bias = b_gla_gate[h * 128 + d]; float cum = 0.f;
      for (int t = tq * 32; t < tq * 32 + 32; ++t) { float z = bias;
#pragma unroll
          for (int k4 = 0; k4 < 4; ++k4) { const f32x4 a = *(const LAS f32x4*)(AL + t * 16 + k4 * 4); z += a[0] * w[4 * k4] + a[1] * w[4 * k4 + 1] + a[2] * w[4 * k4 + 2] + a[3] * w[4 * k4 + 3]; }
          cum += log_sigmoid_(z) * (1.f / 16.f); BL[t * 128 + d] = cum; }
      QT[tq * 128 + d] = cum;
      __syncthreads();
      float off = 0.f;
      for (int q = 0; q < tq; ++q) off += QT[q * 128 + d];
      if (tq > 0) for (int t = tq * 32; t < tq * 32 + 32; ++t) BL[t * 128 + d] += off;
      if (tq == 3) DECL[d] = cum + off;
    }
    __syncthreads();
#pragma unroll 1
    for (int j = 0; j < 4; ++j) { const int it = tid + 512 * j, t = it >> 4, ch = it & 15; const size_t go = (tok0 + t) * 512 + h * 128 + ch * 8;
        const f32x4 b0 = *(const LAS f32x4*)(BL + t * 128 + ch * 8), b1 = *(const LAS f32x4*)(BL + t * 128 + ch * 8 + 4);
        f32x4 k0, k1, q0, q1; pg8::unpack8bf(*(const GAS v4u*)(GK + go), k0, k1); pg8::unpack8bf(*(const GAS v4u*)(GQ + go), q0, q1);
#pragma unroll
        for (int i = 0; i < 4; ++i) { const float e0 = __expf(b0[i]), e1 = __expf(b1[i]); q0[i] *= e0; q1[i] *= e1; k0[i] *= __builtin_amdgcn_rcpf(e0); k1[i] *= __builtin_amdgcn_rcpf(e1); }
        const v4u kw = pg8::pack8bf(k0, k1); *(GAS v4u*)(GK + go) = kw; *(GAS v4u*)(GQ + go) = pg8::pack8bf(q0, q1);
        LAS unsigned short* kt = (LAS unsigned short*)(KT + (ch * 8) * GSTR + t * 2);
        kt[0 * (GSTR / 2)] = (unsigned short)(kw.x & 0xffff); kt[1 * (GSTR / 2)] = (unsigned short)(kw.x >> 16); kt[2 * (GSTR / 2)] = (unsigned short)(kw.y & 0xffff); kt[3 * (GSTR / 2)] = (unsigned short)(kw.y >> 16);
        kt[4 * (GSTR / 2)] = (unsigned short)(kw.z & 0xffff); kt[5 * (GSTR / 2)] = (unsigned short)(kw.z >> 16); kt[6 * (GSTR / 2)] = (unsigned short)(kw.w & 0xffff); kt[7 * (GSTR / 2)] = (unsigned short)(kw.w >> 16); }
    __syncthreads();
#pragma unroll 2
    for (int j = 0; j < 8; ++j) { const int it = tid + 512 * j, t = it >> 5, ch = it & 31; const v4u vw = *(const GAS v4u*)(GV + (tok0 + t) * 1024 + h * 256 + ch * 8);
        LAS unsigned short* vt = (LAS unsigned short*)(VT + (ch * 8) * GSTR + t * 2);
        vt[0 * (GSTR / 2)] = (unsigned short)(vw.x & 0xffff); vt[1 * (GSTR / 2)] = (unsigned short)(vw.x >> 16); vt[2 * (GSTR / 2)] = (unsigned short)(vw.y & 0xffff); vt[3 * (GSTR / 2)] = (unsigned short)(vw.y >> 16);
        vt[4 * (GSTR / 2)] = (unsigned short)(vw.z & 0xffff); vt[5 * (GSTR / 2)] = (unsigned short)(vw.z >> 16); vt[6 * (GSTR / 2)] = (unsigned short)(vw.w & 0xffff); vt[7 * (GSTR / 2)] = (unsigned short)(vw.w >> 16); }
    __syncthreads();
    { const int db = wave & 3; f32x16 acc[4];
#pragma unroll
      for (int j = 0; j < 4; ++j) { acc[j] = f32x16{}; mm32(acc[j], KT + db * 32 * GSTR, VT + ((wave >> 2) * 4 + j) * 32 * GSTR, r32, hi, 0, 8); }
      bf16* ST = WSP(bf16, WS_ST) + (size_t)unit * (128 * 256);
#pragma unroll
      for (int r = 0; r < 16; ++r) { const int d = db * 32 + crow_(r, hi); const float sc = __expf(DECL[d]);
#pragma unroll
          for (int j = 0; j < 4; ++j) { const float v = acc[j][r] * sc, vn = __shfl_xor(v, 1); if ((r32 & 1) == 0) *(GAS unsigned*)(ST + (size_t)d * 256 + ((wave >> 2) * 4 + j) * 32 + r32) = pk2(v, vn); } }
      if (tid < 128) WSP(float, WS_DEC)[(size_t)unit * 128 + tid] = __expf(DECL[tid]);
    }
    __syncthreads();
}
__device__ __forceinline__ void gla_scan_phase(Frame& F) {
    const int gid = F.vcu * 512 + F.tid; if (gid >= 8 * 128 * 128) return;
    const int bh = gid >> 14, d = (gid >> 7) & 127, e2 = gid & 127;
    GAS unsigned* p = (GAS unsigned*)(WSP(bf16, WS_ST) + (size_t)bh * GNC * (128 * 256) + (size_t)d * 256 + 2 * e2); const float* dec = WSP(float, WS_DEC) + (size_t)bh * GNC * 128 + d;
    float s0 = 0.f, s1 = 0.f;
#pragma unroll 8
    for (int c = 0; c < GNC; ++c) { const unsigned w = p[(size_t)c * (128 * 256 / 2)]; const float dc = dec[c * 128];
        p[(size_t)c * (128 * 256 / 2)] = pk2(s0, s1); s0 = dc * s0 + pg8::bflo(w); s1 = dc * s1 + pg8::bfhi(w); }
}
__device__ __forceinline__ void gla_out_unit(Frame& F, int unit, const float* g_gla_out) {
    const int tid = F.tid, lane = F.lane, wave = F.wave, r32 = lane & 31, hi = lane >> 5;
    const int bh = unit / GNC, c = unit % GNC, b = bh >> 2, h = bh & 3; const size_t tok0 = (size_t)b * SEQ + (size_t)c * GC;
    LAS unsigned char* lds = F.lds;
    LAS unsigned char* QL = lds;
    LAS unsigned char* KA = lds + 34816;
    LAS unsigned char* VT = lds + 69632;
    LAS unsigned char* SL = lds + 104448;
    LAS float* XS = (LAS float*)(lds + EXCH_OFF);
    const bf16* GQ = WSP(bf16, WS_GQ); const bf16* GK = WSP(bf16, WS_GK); bf16* GV = WSP(bf16, WS_GV); const bf16* ST = WSP(bf16, WS_ST) + (size_t)unit * (128 * 256);
#pragma unroll
    for (int j = 0; j < 4; ++j) { const int it = tid + 512 * j, t = it >> 4, ch = it & 15; const size_t go = (tok0 + t) * 512 + h * 128 + ch * 8;
        *(LAS v4u*)(QL + t * GSTR + ch * 16) = *(const GAS v4u*)(GQ + go); *(LAS v4u*)(KA + t * GSTR + ch * 16) = *(const GAS v4u*)(GK + go); }
    __syncthreads();
    const int ib = wave >> 1; f32x16 aa[2];
#pragma unroll
    for (int q = 0; q < 2; ++q) { const int jb = 2 * (wave & 1) + q; aa[q] = f32x16{};
        if (jb <= ib) { mm32(aa[q], KA + jb * 32 * GSTR, QL + ib * 32 * GSTR, r32, hi, 0, 8);
            if (jb == ib) {
#pragma unroll
                for (int r = 0; r < 16; ++r) if (crow_(r, hi) > r32) aa[q][r] = 0.f; } } }
    __syncthreads();
#pragma unroll
    for (int q = 0; q < 2; ++q) { const int jb = 2 * (wave & 1) + q;
#pragma unroll
        for (int g = 0; g < 4; ++g) { const unsigned lo = pg8::cvt_pk_bf16(aa[q][4 * g], aa[q][4 * g + 1]), hi2 = pg8::cvt_pk_bf16(aa[q][4 * g + 2], aa[q][4 * g + 3]);
            typedef unsigned u32x2v __attribute__((ext_vector_type(2)));
            *(LAS u32x2v*)(KA + (ib * 32 + r32) * GSTR + (jb * 32 + 8 * g + 4 * hi) * 2) = (u32x2v){lo, hi2}; } }
    const int ob = wave & 3; f32x16 oo[4];
#pragma unroll
    for (int hf = 0; hf < 2; ++hf) {
#pragma unroll
        for (int j = 0; j < 4; ++j) { const int it = tid + 512 * j, t = it >> 4, ch = it & 15;
            const v4u vw = *(const GAS v4u*)(GV + (tok0 + t) * 1024 + h * 256 + hf * 128 + ch * 8); LAS unsigned short* vt = (LAS unsigned short*)(VT + (ch * 8) * GSTR + t * 2);
            vt[0 * (GSTR / 2)] = (unsigned short)(vw.x & 0xffff); vt[1 * (GSTR / 2)] = (unsigned short)(vw.x >> 16); vt[2 * (GSTR / 2)] = (unsigned short)(vw.y & 0xffff); vt[3 * (GSTR / 2)] = (unsigned short)(vw.y >> 16);
            vt[4 * (GSTR / 2)] = (unsigned short)(vw.z & 0xffff); vt[5 * (GSTR / 2)] = (unsigned short)(vw.z >> 16); vt[6 * (GSTR / 2)] = (unsigned short)(vw.w & 0xffff); vt[7 * (GSTR / 2)] = (unsigned short)(vw.w >> 16);
            const v4u sw = *(const GAS v4u*)(ST + (size_t)t * 256 + hf * 128 + ch * 8); LAS unsigned short* st = (LAS unsigned short*)(SL + (ch * 8) * GSTR + t * 2);
            st[0 * (GSTR / 2)] = (unsigned short)(sw.x & 0xffff); st[1 * (GSTR / 2)] = (unsigned short)(sw.x >> 16); st[2 * (GSTR / 2)] = (unsigned short)(sw.y & 0xffff); st[3 * (GSTR / 2)] = (unsigned short)(sw.y >> 16);
            st[4 * (GSTR / 2)] = (unsigned short)(sw.z & 0xffff); st[5 * (GSTR / 2)] = (unsigned short)(sw.z >> 16); st[6 * (GSTR / 2)] = (unsigned short)(sw.w & 0xffff); st[7 * (GSTR / 2)] = (unsigned short)(sw.w >> 16); }
        __syncthreads();
#pragma unroll
        for (int q = 0; q < 2; ++q) { const int eb = (wave >> 2) * 2 + q; f32x16 a = f32x16{};
            mm32(a, KA + ob * 32 * GSTR, VT + eb * 32 * GSTR, r32, hi, 0, 2 * (ob + 1));
            mm32(a, QL + ob * 32 * GSTR, SL + eb * 32 * GSTR, r32, hi, 0, 8);
            oo[hf * 2 + q] = a; }
        __syncthreads();
    }
    float ssr[16];
#pragma unroll
    for (int r = 0; r < 16; ++r) { float s = oo[0][r] * oo[0][r] + oo[1][r] * oo[1][r] + oo[2][r] * oo[2][r] + oo[3][r] * oo[3][r];
#pragma unroll
        for (int o = 1; o < 32; o <<= 1) s += __shfl_xor(s, o);
        ssr[r] = s; if (r32 == 0) XS[wave * 32 + hi * 16 + r] = s; }
    __syncthreads();
#pragma unroll
    for (int r = 0; r < 16; ++r) { const float tot = ssr[r] + XS[(wave ^ 4) * 32 + hi * 16 + r]; const float rs = __builtin_amdgcn_rsqf(tot * (1.f / 256.f) + EPS); const int t = ob * 32 + crow_(r, hi);
#pragma unroll
        for (int k = 0; k < 4; ++k) { const int e = (k >> 1) * 128 + ((wave >> 2) * 2 + (k & 1)) * 32 + r32; const float v = oo[k][r] * rs * g_gla_out[e], vn = __shfl_xor(v, 1);
            if ((r32 & 1) == 0) *(GAS unsigned*)(GV + (tok0 + t) * 1024 + h * 256 + e) = pk2(v, vn); } }
    __syncthreads();
}

struct MlaSrc {
    const char *KN, *KPE, *VM; bf16* O; int h, orow0; unsigned offA, offP, ldsA, ldsP, vst0, vst1;
    __device__ __forceinline__ void init(int tid) { offA = (unsigned)((tid >> 4) * 2048 + (tid & 15) * 16); offP = (unsigned)((tid >> 3) * 128 + (tid & 7) * 16);
        ldsA = (unsigned)((tid >> 4) * 400 + (tid & 15) * 16); ldsP = (unsigned)((tid >> 3) * 400 + 256 + (tid & 7) * 16); vst0 = (unsigned)att::v_st(tid >> 4, (tid & 15) * 8); vst1 = (unsigned)att::v_st(32 + (tid >> 4), (tid & 15) * 8); }
    __device__ __forceinline__ void load(int t, att::u32x4 (&sk)[3], att::u32x4 (&sv)[2]) const {
        const char* kb = KN + (size_t)t * (64 * 2048); const char* vb = VM + (size_t)t * (64 * 2048); const char* pb = KPE + (size_t)t * (64 * 128);
        sk[0] = *(const GAS att::u32x4*)(kb + offA); sk[1] = *(const GAS att::u32x4*)(kb + 32 * 2048 + offA); sk[2] = *(const GAS att::u32x4*)(pb + offP);
        sv[0] = *(const GAS att::u32x4*)(vb + offA); sv[1] = *(const GAS att::u32x4*)(vb + 32 * 2048 + offA);
    }
    __device__ __forceinline__ void write(LAS char* kbuf, LAS char* vbuf, const att::u32x4 (&sk)[3], const att::u32x4 (&sv)[2]) const {
        *(LAS att::u32x4*)(kbuf + ldsA) = sk[0]; *(LAS att::u32x4*)(kbuf + ldsA + 32 * 400) = sk[1]; *(LAS att::u32x4*)(kbuf + ldsP) = sk[2];
        *(LAS att::u32x4*)(vbuf + vst0) = sv[0]; *(LAS att::u32x4*)(vbuf + vst1) = sv[1];
    }
    __device__ __forceinline__ void store(int orow, int col, float v, float vn) const { *(GAS unsigned*)(O + (size_t)(orow0 + orow) * 1536 + h * 192 + col) = pk2(v, vn); }
};
__device__ __forceinline__ void mla_unit(Frame& F, int b, int h, int qb, const float* g_q_nope, const float* g_q_rope) {
    const int lane = F.lane, r32 = lane & 31, hi = lane >> 5, wid = F.wave;
    bf16* Q = WSP(bf16, WS_Q); const float* COS = WSP(float, WS_ROPE); const float* SIN = COS + (size_t)M * 32;
    const size_t rowbase = (size_t)b * SEQ; const int row = qb * 256 + wid * 32 + r32; const size_t grow = rowbase + row;
    att::bf16x8 qr[12];
    { f32x4 v[12][2]; float sn = 0.f, sr = 0.f;
#pragma unroll
      for (int d0 = 0; d0 < 12; ++d0) { pg8::unpack8bf(*(const GAS v4u*)(Q + grow * 1536 + h * 192 + d0 * 16 + hi * 8), v[d0][0], v[d0][1]);
          const f32x4 q = v[d0][0] * v[d0][0] + v[d0][1] * v[d0][1]; const float s = (q[0] + q[1]) + (q[2] + q[3]); if (d0 < 8) sn += s; else sr += s; }
      { auto rr = __builtin_amdgcn_permlane32_swap(__float_as_uint(sn), __float_as_uint(sn), false, false); sn = __uint_as_float(rr[0]) + __uint_as_float(rr[1]); }
      { auto rr = __builtin_amdgcn_permlane32_swap(__float_as_uint(sr), __float_as_uint(sr), false, false); sr = __uint_as_float(rr[0]) + __uint_as_float(rr[1]); }
      const float rn = __builtin_amdgcn_rsqf(sn * (1.f / 128.f) + EPS) * QK_SCALE_L2, rr_ = __builtin_amdgcn_rsqf(sr * (1.f / 64.f) + EPS) * QK_SCALE_L2;
#pragma unroll
      for (int d0 = 0; d0 < 8; ++d0) { const f32x4 g0 = *(const f32x4*)(g_q_nope + d0 * 16 + hi * 8), g1 = *(const f32x4*)(g_q_nope + d0 * 16 + hi * 8 + 4); qr[d0] = att::pack8(v[d0][0] * rn * g0, v[d0][1] * rn * g1); }
#pragma unroll
      for (int p = 0; p < 2; ++p) {
          const int i0 = 16 * p + 8 * hi;
          const f32x4 ga0 = *(const f32x4*)(g_q_rope + i0), ga1 = *(const f32x4*)(g_q_rope + i0 + 4), gb0 = *(const f32x4*)(g_q_rope + 32 + i0), gb1 = *(const f32x4*)(g_q_rope + 32 + i0 + 4);
          const f32x4 c0 = *(const f32x4*)(COS + grow * 32 + i0), c1 = *(const f32x4*)(COS + grow * 32 + i0 + 4), s0 = *(const f32x4*)(SIN + grow * 32 + i0), s1 = *(const f32x4*)(SIN + grow * 32 + i0 + 4);
          const f32x4 a0 = v[8 + p][0] * rr_ * ga0, a1 = v[8 + p][1] * rr_ * ga1, b0 = v[10 + p][0] * rr_ * gb0, b1 = v[10 + p][1] * rr_ * gb1;
          qr[8 + p] = att::pack8(a0 * c0 - b0 * s0, a1 * c1 - b1 * s1); qr[10 + p] = att::pack8(a0 * s0 + b0 * c0, a1 * s1 + b1 * c1); }
    }
    MlaSrc S; S.KN = (const char*)F.out + (rowbase * 1024 + h * 128) * 2; S.VM = (const char*)F.out + ((size_t)M * 1024 + rowbase * 1024 + h * 128) * 2; S.KPE = (const char*)WSP(bf16, WS_KPE) + rowbase * 128;
    S.O = Q; S.h = h; S.orow0 = (int)(rowbase + qb * 256 + wid * 32); S.init(F.tid);
    att::attn_unit<192, 128, true, true, MlaSrc>((LAS char*)F.lds, qr, 4 * (qb + 1), wid * 32, S);
}
struct MemSrc {
    const char* KV; const float* gk; bf16* O; int hm, orow0; unsigned offK, offV, ldsK, vst0, vst1, gko;
    __device__ __forceinline__ void init(int tid) { offK = (unsigned)((tid >> 3) * 2560 + hm * 128 + (tid & 7) * 16); offV = (unsigned)((tid >> 4) * 2560 + 512 + hm * 512 + (tid & 15) * 16);
        ldsK = (unsigned)((tid >> 3) * 144 + (tid & 7) * 16); vst0 = (unsigned)att::v_st(tid >> 4, (tid & 15) * 8); vst1 = (unsigned)att::v_st(32 + (tid >> 4), (tid & 15) * 8); gko = (unsigned)((tid & 7) * 8); }
    __device__ __forceinline__ void load(int t, att::u32x4 (&sk)[1], att::u32x4 (&sv)[4]) const {
        const char* kb = KV + (size_t)t * (64 * 2560);
        f32x4 a0, a1; pg8::unpack8bf(*(const GAS att::u32x4*)(kb + offK), a0, a1);
        const f32x4 q = a0 * a0 + a1 * a1; float s = (q[0] + q[1]) + (q[2] + q[3]); s += __shfl_xor(s, 1); s += __shfl_xor(s, 2); s += __shfl_xor(s, 4);
        const float rs = __builtin_amdgcn_rsqf(s * (1.f / 64.f) + EPS);
        sk[0] = pg8::pack8bf(a0 * rs * *(const f32x4*)(gk + gko), a1 * rs * *(const f32x4*)(gk + gko + 4));
        sv[0] = *(const GAS att::u32x4*)(kb + offV); sv[1] = *(const GAS att::u32x4*)(kb + 32 * 2560 + offV); sv[2] = *(const GAS att::u32x4*)(kb + 256 + offV); sv[3] = *(const GAS att::u32x4*)(kb + 32 * 2560 + 256 + offV);
    }
    __device__ __forceinline__ void write(LAS char* kbuf, LAS char* vbuf, const att::u32x4 (&sk)[1], const att::u32x4 (&sv)[4]) const {
        *(LAS att::u32x4*)(kbuf + ldsK) = sk[0];
        *(LAS att::u32x4*)(vbuf + vst0) = sv[0]; *(LAS att::u32x4*)(vbuf + vst1) = sv[1]; *(LAS att::u32x4*)(vbuf + 16384 + vst0) = sv[2]; *(LAS att::u32x4*)(vbuf + 16384 + vst1) = sv[3];
    }
    __device__ __forceinline__ void store(int orow, int col, float v, float vn) const { *(GAS unsigned*)(O + (size_t)(orow0 + orow) * 1024 + hm * 256 + col) = pk2(v, vn); }
};
__device__ __forceinline__ void mem_unit(Frame& F, int pm, int hm, const float* g_q_mem, const float* g_k_mem) {
    const int lane = F.lane, r32 = lane & 31, hi = lane >> 5, wid = F.wave;
    const bf16* QM = WSP(bf16, WS_QMEM); const size_t grow = (size_t)pm * 256 + wid * 32 + r32;
    att::bf16x8 qr[4];
    { f32x4 v[4][2]; float sn = 0.f;
#pragma unroll
      for (int d0 = 0; d0 < 4; ++d0) { pg8::unpack8bf(*(const GAS v4u*)(QM + grow * 256 + hm * 64 + d0 * 16 + hi * 8), v[d0][0], v[d0][1]); const f32x4 q = v[d0][0] * v[d0][0] + v[d0][1] * v[d0][1]; sn += (q[0] + q[1]) + (q[2] + q[3]); }
      { auto rr = __builtin_amdgcn_permlane32_swap(__float_as_uint(sn), __float_as_uint(sn), false, false); sn = __uint_as_float(rr[0]) + __uint_as_float(rr[1]); }
      const float rn = __builtin_amdgcn_rsqf(sn * (1.f / 64.f) + EPS) * MEM_SCALE_L2;
#pragma unroll
      for (int d0 = 0; d0 < 4; ++d0) { const f32x4 g0 = *(const f32x4*)(g_q_mem + d0 * 16 + hi * 8), g1 = *(const f32x4*)(g_q_mem + d0 * 16 + hi * 8 + 4); qr[d0] = att::pack8(v[d0][0] * rn * g0, v[d0][1] * rn * g1); } }
    MemSrc S; S.KV = (const char*)WSP(bf16, WS_KVM) + (size_t)(pm / 32) * (MEM_LEN * 2560); S.gk = g_k_mem; S.O = (bf16*)F.out; S.hm = hm; S.orow0 = pm * 256 + wid * 32; S.init(F.tid);
    att::attn_unit<64, 256, false, false, MemSrc>((LAS char*)F.lds, qr, 4, 0, S);
}

struct Args { const void* in[23]; float* out; unsigned char* ws; RopeArg rope; int ph_lo, ph_hi, li, pad; };
__global__ void __launch_bounds__(NWAVES * 64, 2) hybrid_fwd(Args args) {
    extern __shared__ __attribute__((aligned(16))) unsigned char lds[];
    Frame F;
    F.lds = (LAS unsigned char*)lds;
    F.MISC = (volatile LAS unsigned*)(F.lds + MISC_OFF);
    F.tid = threadIdx.x; F.lane = F.tid & 63; F.wave = __builtin_amdgcn_readfirstlane(F.tid >> 6);
    F.G = gridDim.x; { const int bx = blockIdx.x; F.vcu = (F.G % 8 == 0) ? (bx % 8) * (F.G / 8) + bx / 8 : bx; }
    F.ws = args.ws; F.out = args.out; F.ctl = (gu32*)(args.ws + WS_CTL);
#define INF(k) ((const float*)args.in[k])
    for (int u = F.tid; u < (LDS_BYTES - LDSCTL_OFF) / 4; u += NWAVES * 64) ((LAS unsigned*)(F.lds + LDSCTL_OFF))[u] = 0u;
    __syncthreads();
    XcdBarrier bar; bar.bar = (unsigned*)(F.ctl + CW_BAR); bar.x = 0; bar.st = nullptr;
    if (N_LAUNCHES != PER_PHASE) bar = xcd_barrier_post((unsigned*)(F.ctl + CW_BAR), F.MISC + 8);
#define GRID_BAR(seam) do { if (N_LAUNCHES == PER_PHASE) { if (F.tid == 0) __hip_atomic_store(F.ctl + CW_TMO, 0xBADBA0u | (unsigned)(seam), RLX_AGENT); } else { xcd_barrier(bar); } } while (0)
    const int lo = args.ph_lo, hi = args.ph_hi;
#ifndef PHMASK
#define PHMASK 0x3ff
#endif
#define IN(k) (((PHMASK >> (k)) & 1) && lo <= (k) && (k) < hi)
#define BOTH(k) (IN(k) && IN((k) + 1))
    bf16* const Win_t = WSP(bf16, WS_WIN); bf16* const XN = WSP(bf16, WS_XN);
    bf16* const KN = (bf16*)F.out; bf16* const VM = (bf16*)F.out + (size_t)M * 1024; bf16* const OMEM = (bf16*)F.out; bf16* const Y = WSP(bf16, WS_GQ);

    if (IN(0)) { const P0In I{INF(0), INF(1), (const int*)args.in[2], INF(3), INF(4), INF(6), INF(7), INF(15), INF(16), INF(19), INF(21), INF(22)}; p0_prologue(F, I, args.rope); if (BOTH(0)) GRID_BAR(0); }

    if (IN(1)) {
        pg8::Gemm g{XN, Win_t, M + MROWS, NPAD + 1280, D}; pg8::ProjOrder S; S.init(M, NP1, F.G, (int)blockIdx.x);
        pg8::EpiProj E{WSP(bf16, WS_Q), WSP(bf16, WS_CKV), WSP(bf16, WS_KRAG), WSP(bf16, WS_GQ), WSP(bf16, WS_GK), WSP(bf16, WS_GV), WSP(bf16, WS_QMEM), WSP(bf16, WS_KVM)};
        pg8::gemm_phase<pg8::EpiProj, pg8::ProjOrder, true, true>(F.lds + RING_OFF, g, S, E);
        if (BOTH(1)) GRID_BAR(1);
    }
    if (IN(2)) {
#ifndef SKIP_KVUP
        { pg8::Gemm g{WSP(bf16, WS_CKV), WSP(bf16, WS_WUKV), M, 2048, 256}; pg8::StaticOrder S; S.init(M, 2048, F.G, (int)blockIdx.x);
          pg8::EpiKvUp E{WSP(bf16, WS_CKV), KN, VM, INF(9), (LAS float*)(F.lds + EXCH_OFF), EPS};
          pg8::gemm_phase<pg8::EpiKvUp, pg8::StaticOrder, true, true>(F.lds + RING_OFF, g, S, E); }
#endif
        __syncthreads();
#ifndef SKIP_KPE
        kpe_phase(F, INF(11));
#endif
#ifndef SKIP_G1
        for (int u = F.vcu; u < BATCH * 4 * GNC; u += F.G) gla_local_unit(F, u, INF(12), INF(13));
#endif
        if (BOTH(2)) GRID_BAR(2);
    }
    if (IN(3)) {
        gla_scan_phase(F);
        for (int it = F.vcu; it < BATCH * 8 * 16; it += F.G) { const int bh = it >> 4, s = it & 15; mla_unit(F, bh >> 3, bh & 7, s, INF(8), INF(10)); mla_unit(F, bh >> 3, bh & 7, 31 - s, INF(8), INF(10)); }
        if (BOTH(3)) GRID_BAR(3);
    }
    if (IN(4)) {
#ifndef SKIP_G3
        for (int u = F.vcu; u < BATCH * 4 * GNC; u += F.G) gla_out_unit(F, u, INF(14));
#endif
#ifndef SKIP_MEM
        for (int u = F.vcu; u < 64 * 4; u += F.G) mem_unit(F, u >> 2, u & 3, INF(17), INF(18));
#endif
        if (BOTH(4)) GRID_BAR(4);
    }
    if (IN(5)) {
        pg8::Gemm g{XN, Win_t, M, NPAD, D}; pg8::MergeOrder S; S.init(M, 1024, F.G, (int)blockIdx.x);
        pg8::EpiMerge E{INF(5), WSP(bf16, WS_Q), WSP(bf16, WS_GV), OMEM, Y};
        pg8::gemm_phase<pg8::EpiMerge, pg8::MergeOrder, true, true>(F.lds + RING_OFF, g, S, E);
        if (BOTH(5)) GRID_BAR(5);
    }
    if (IN(6)) {
        pg8::Gemm g{Y, WSP(bf16, WS_WO), M, D, D}; pg8::StaticOrder S; S.init(M, D, F.G, (int)blockIdx.x);
        pg8::EpiResF32 E{INF(0), F.out, D};
        pg8::gemm_phase<pg8::EpiResF32, pg8::StaticOrder, true, true>(F.lds + RING_OFF, g, S, E);
        if (BOTH(6)) GRID_BAR(6);
    }
    if (IN(7)) {
        const int gw = F.vcu * NWAVES + F.wave, NGW = F.G * NWAVES;
        for (int m = gw; m < M; m += NGW) rms_row_to_bf16(F.lane, F.out + (size_t)m * D, INF(20), XN + (size_t)m * D);
        if (BOTH(7)) GRID_BAR(7);
    }
    if (IN(8)) {
        pg8::Gemm g{XN, WSP(bf16, WS_WUP), M, FF, D}; pg8::StaticOrder S; S.init(M, FF, F.G, (int)blockIdx.x);
        pg8::EpiRelu2 E{WSP(bf16, WS_H), FF};
        pg8::gemm_phase<pg8::EpiRelu2, pg8::StaticOrder, true, true>(F.lds + RING_OFF, g, S, E);
        if (BOTH(8)) GRID_BAR(8);
    }
    if (IN(9)) {
        pg8::Gemm g{WSP(bf16, WS_H), WSP(bf16, WS_WDN), M, D, FF}; pg8::StaticOrder S; S.init(M, D, F.G, (int)blockIdx.x);
        pg8::EpiResF32 E{F.out, F.out, D};
        pg8::gemm_phase<pg8::EpiResF32, pg8::StaticOrder, true, true>(F.lds + RING_OFF, g, S, E);
    }
#undef IN
#undef BOTH
}

extern "C" void kernel_launch(void* const* d_in, const int* in_sizes, int n_in, void* d_out, int out_size, void* d_ws, size_t ws_size, hipStream_t stream) {
    static int grid = 0;
    if (grid == 0) {
        if (n_in != 23 || in_sizes[0] != M * D || out_size != M * D || ws_size < WS_END) { fprintf(stderr, "kernel_launch: shape mismatch (n_in %d in0 %d out %d ws %zu)\n", n_in, n_in > 0 ? in_sizes[0] : -1, out_size, ws_size); grid = -1; return; }
        int dev = 0, cus = 0;
        if (hipGetDevice(&dev) != hipSuccess || hipDeviceGetAttribute(&cus, hipDeviceAttributeMultiprocessorCount, dev) != hipSuccess) { grid = -1; return; }
        if (hipFuncSetAttribute((const void*)hybrid_fwd, hipFuncAttributeMaxDynamicSharedMemorySize, LDS_BYTES) != hipSuccess) { fprintf(stderr, "kernel_launch: hipFuncSetAttribute failed\n"); grid = -1; return; }
        int per_cu = 0;
        if (hipOccupancyMaxActiveBlocksPerMultiprocessor(&per_cu, (const void*)hybrid_fwd, NWAVES * 64, LDS_BYTES) != hipSuccess || per_cu < 1) fprintf(stderr, "kernel_launch: occupancy query says %d\n", per_cu);
        (void)hipGetLastError();
        grid = cus;
        if (grid != 256) fprintf(stderr, "kernel_launch: %d CUs (built for 256)\n", grid);
    }
    if (grid < 0) return;
    (void)hipMemsetAsync((char*)d_ws + WS_CTL, 0, CTL_ZERO_BYTES, stream);
    Args a{};
    for (int i = 0; i < 23; ++i) a.in[i] = d_in[i];
    a.out = (float*)d_out; a.ws = (unsigned char*)d_ws;
    for (int i = 0; i < 32; ++i) a.rope.inv_rev[i] = pow(10000.0, -(double)(2 * i) / 64.0) / 6.283185307179586476925286766559;
    if (N_LAUNCHES == 1) { a.ph_lo = 0; a.ph_hi = PER_PHASE; a.li = 0; hipLaunchKernelGGL(hybrid_fwd, dim3(grid), dim3(NWAVES * 64), LDS_BYTES, stream, a); }
    else for (int li = 0; li < PER_PHASE; ++li) { a.ph_lo = li; a.ph_hi = li + 1; a.li = li; hipLaunchKernelGGL(hybrid_fwd, dim3(grid), dim3(NWAVES * 64), LDS_BYTES, stream, a); }
}
```

```cpp
#include <hip/hip_runtime.h>
#include <cstdio>
#include <cstdint>
#include <cmath>
namespace pg8 {
#define PG8_LAS __attribute__((address_space(3)))
typedef unsigned short bf16_t;
typedef short bf16x8 __attribute__((ext_vector_type(8)));
typedef float f32x4 __attribute__((ext_vector_type(4)));
typedef unsigned u32x4 __attribute__((ext_vector_type(4)));
constexpr int BM = 256, BK = 64, HALF = 128, HTB = HALF * BK * 2  , STAGE_BYTES = 8 * HTB, NXCD = 8, WGM = 8;

__host__ __device__ __forceinline__ int lds_byte(int r, int c) { const int st = (r >> 4) * 2 + (c >> 5), rr = r & 15, cc = c & 31, ob = rr * 64 + cc * 2; return st * 1024 + (ob ^ (((ob >> 9) & 1) << 5)); }
__host__ __device__ __forceinline__ void stage_rc(int b, int& R, int& C) { const int st = b / 1024, sb = b % 1024, swz = sb ^ (((sb >> 9) & 1) << 5); R = (st >> 1) * 16 + swz / 64; C = (st & 1) * 32 + (swz % 64) / 2; }
__host__ __device__ __forceinline__ int perm32(int rho) { const int n = rho >> 4, i = rho & 15; return 8 * (i >> 2) + 4 * n + (i & 3); }

struct Unit { int pm, pn; };
struct Gemm { const bf16_t* A; const bf16_t* Bt; int M, N, K; };

struct StaticOrder {
    int nM, nN, nwg, G, c;
    __host__ __device__ void init(int M, int N, int G_, int c_) { nM = M / BM; nN = N / BM; nwg = nM * nN; G = G_; c = c_; }
    __host__ __device__ bool next(int i, Unit& u) const {
        const long L = (long)i * G + c; if (L >= nwg) return false;
        int wgid = (int)L; { const int q = nwg / NXCD, r = nwg % NXCD, xcd = wgid % NXCD, off = wgid / NXCD; wgid = (xcd < r ? xcd * (q + 1) : r * (q + 1) + (xcd - r) * q) + off; }
        const int nig = WGM * nN, gid = wgid / nig, fm = gid * WGM, gsz = (nM - fm) < WGM ? (nM - fm) : WGM;
        u.pm = fm + ((wgid % nig) % gsz); u.pn = (wgid % nig) / gsz; return true;
    }
    __device__ __forceinline__ void a_ready(const Unit&) const {}
    __device__ __forceinline__ void done(const Unit&) const {}
};

__device__ __forceinline__ unsigned cvt_pk_bf16(float lo, float hi) { unsigned r; asm volatile("v_cvt_pk_bf16_f32 %0, %1, %2" : "=v"(r) : "v"(lo), "v"(hi)); return r; }
typedef float f32x2 __attribute__((ext_vector_type(2)));
__device__ __forceinline__ u32x4 pack8bf(const f32x4 v0, const f32x4 v1) { u32x4 w; w.x = cvt_pk_bf16(v0[0], v0[1]); w.y = cvt_pk_bf16(v0[2], v0[3]); w.z = cvt_pk_bf16(v1[0], v1[1]); w.w = cvt_pk_bf16(v1[2], v1[3]); return w; }
__device__ __forceinline__ float bflo(unsigned w) { return __uint_as_float(w << 16); }
__device__ __forceinline__ float bfhi(unsigned w) { return __uint_as_float(w & 0xffff0000u); }
__device__ __forceinline__ void unpack8bf(const u32x4 w, f32x4& a, f32x4& b) { a = (f32x4){bflo(w.x), bfhi(w.x), bflo(w.y), bfhi(w.y)}; b = (f32x4){bflo(w.z), bfhi(w.z), bflo(w.w), bfhi(w.w)}; }
__device__ __forceinline__ float sigmoidf_(float x) { return __builtin_amdgcn_rcpf(1.0f + __builtin_amdgcn_exp2f(-1.4426950408889634f * x)); }

struct EpiProj {
    static constexpr bool PERM = true, AFTER_DRAIN = false;
    bf16_t *Q, *CKV, *KRAG, *GQ, *GK, *GV, *QMEM, *KVM;
    __device__ __forceinline__ void operator()(const f32x4 (&acc)[2][2][4][2], const Unit& u, int wr, int wc, int fr, int fq) const {
        bf16_t* base; int ld, colt, nh = 2, rowb = u.pm * BM; const int pn = u.pn;
        if (pn < 6) { base = Q; ld = 1536; colt = pn * 256; }
        else if (pn == 6) { base = CKV; ld = 256; colt = 0; }
        else if (pn == 7) { base = KRAG; ld = 128; colt = 0; nh = 1; }
        else if (pn < 10) { base = GQ; ld = 512; colt = (pn - 8) * 256; }
        else if (pn < 12) { base = GK; ld = 512; colt = (pn - 10) * 256; }
        else if (pn < 16) { base = GV; ld = 1024; colt = (pn - 12) * 256; }
        else if (pn == 16) { base = QMEM; ld = 256; colt = 0; }
        else { base = KVM; ld = 1280; colt = (pn - 33) * 256; rowb = (u.pm - 64) * BM; }
        const int row0 = rowb + wr * 64 + fr, col0 = colt + wc * 32 + 8 * fq;
#pragma unroll
        for (int ai = 0; ai < 2; ++ai)
#pragma unroll
            for (int m = 0; m < 4; ++m) { bf16_t* rowp = base + (size_t)(row0 + ai * HALF + m * 16) * ld + col0;
#pragma unroll
                for (int bj = 0; bj < 2; ++bj) if (bj < nh) *(u32x4*)(rowp + bj * HALF) = pack8bf(acc[ai][bj][m][0], acc[ai][bj][m][1]); }
    }
};
struct EpiKvUp {
    static constexpr bool PERM = true, AFTER_DRAIN = false;
    const bf16_t* CKV; bf16_t *KN, *VM; const float* gk; PG8_LAS float* T; float eps;
    __device__ __forceinline__ void operator()(const f32x4 (&acc)[2][2][4][2], const Unit& u, int wr, int wc, int fr, int fq) const {
        typedef float f32x2v __attribute__((ext_vector_type(2)));
        PG8_LAS f32x2v* T2 = (PG8_LAS f32x2v*)T;
        asm volatile("" : "+v"(fr), "+v"(fq));
#pragma unroll
        for (int ai = 0; ai < 2; ++ai)
#pragma unroll
            for (int m = 0; m < 4; ++m) { const int rl = ai * HALF + wr * 64 + m * 16 + fr; const size_t row = (size_t)u.pm * BM + rl;
                const f32x4 a = acc[ai][0][m][0], b = acc[ai][0][m][1];
                float sy = (a[0] * a[0] + a[1] * a[1]) + (a[2] * a[2] + a[3] * a[3]) + (b[0] * b[0] + b[1] * b[1]) + (b[2] * b[2] + b[3] * b[3]);
                const u32x4* cp = (const u32x4*)(CKV + row * 256 + (wc * 4 + fq) * 16); f32x4 c0, c1, c2, c3; unpack8bf(cp[0], c0, c1); unpack8bf(cp[1], c2, c3);
                const f32x4 q = c0 * c0 + c1 * c1 + c2 * c2 + c3 * c3; float sc = (q[0] + q[1]) + (q[2] + q[3]);
                sy += __shfl_xor(sy, 16); sy += __shfl_xor(sy, 32); sc += __shfl_xor(sc, 16); sc += __shfl_xor(sc, 32);
                if (fq == 0) T2[rl * 4 + wc] = (f32x2v){sc, sy}; asm volatile("" ::: "memory"); }
        asm volatile("s_waitcnt lgkmcnt(0)" ::: "memory"); __builtin_amdgcn_s_barrier(); asm volatile("" ::: "memory");
        const int h = u.pn, col0 = h * 128 + wc * 32 + 8 * fq;
        const f32x4 g0 = *(const f32x4*)(gk + wc * 32 + 8 * fq), g1 = *(const f32x4*)(gk + wc * 32 + 8 * fq + 4);
#pragma unroll
        for (int ai = 0; ai < 2; ++ai)
#pragma unroll
            for (int m = 0; m < 4; ++m) { const int rl = ai * HALF + wr * 64 + m * 16 + fr; const size_t row = (size_t)u.pm * BM + rl;
                const f32x2v t0 = T2[rl * 4 + 0], t1 = T2[rl * 4 + 1], t2 = T2[rl * 4 + 2], t3 = T2[rl * 4 + 3];
                const float sc = (t0.x + t1.x) + (t2.x + t3.x), sy = (t0.y + t1.y) + (t2.y + t3.y);
                const float al = __builtin_amdgcn_rsqf(sc * (1.0f / 256.0f) + eps), kf = al * __builtin_amdgcn_rsqf(al * al * sy * (1.0f / 128.0f) + eps);
                *(u32x4*)(KN + row * 1024 + col0) = pack8bf(acc[ai][0][m][0] * kf * g0, acc[ai][0][m][1] * kf * g1);
                *(u32x4*)(VM + row * 1024 + col0) = pack8bf(acc[ai][1][m][0] * al, acc[ai][1][m][1] * al); asm volatile("" ::: "memory"); }
    }
};
struct EpiMerge {
    static constexpr bool PERM = true, AFTER_DRAIN = false;
    const float* bgate; bf16_t *QB, *GV, *OMEM, *Y; bf16_t *QBw, *GVw; unsigned rmask;
    __device__ __forceinline__ void operator()(const f32x4 (&acc)[2][2][4][2], const Unit& u, int wr, int wc, int fr, int fq) const {
        const int sub = (u.pn - 17) >> 2, pny = (u.pn - 17) & 3;
        asm volatile("" : "+v"(fr), "+v"(fq));
        const int row0 = u.pm * BM + wr * 64 + fr;
        const bf16_t* __restrict__ rQ = QB; const bf16_t* __restrict__ rG = GV; const bf16_t* __restrict__ rM = OMEM; bf16_t* __restrict__ wQ = QBw; bf16_t* __restrict__ wG = GVw; bf16_t* __restrict__ wY = Y;
#pragma unroll
        for (int bj = 0; bj < 2; ++bj) { const int cy = pny * 256 + bj * HALF + wc * 32 + 8 * fq;
            const int cq = (cy >> 7) * 192 + (cy & 127);
            f32x4 b0 = {0.f, 0.f, 0.f, 0.f}, b1 = b0;
            if (sub > 0) { b0 = *(const f32x4*)(bgate + (sub - 1) * 1024 + cy); b1 = *(const f32x4*)(bgate + (sub - 1) * 1024 + cy + 4); }
#pragma unroll
            for (int am = 0; am < 4; ++am) { const int ai = am >> 1, mb = (am & 1) * 2;
                u32x4 lA[2], lB[2], lC[2];
#pragma unroll
                for (int mm = 0; mm < 2; ++mm) { const int m = mb + mm; const size_t row = (size_t)(row0 + ai * HALF + m * 16);
                    if (sub == 0 || sub == 2) lA[mm] = *(const u32x4*)(rG + row * 1024 + cy);
                    else if (sub == 1) lA[mm] = *(const u32x4*)(rQ + row * 1536 + cq);
                    else { lA[mm] = *(const u32x4*)(rM + row * 1024 + cy); lB[mm] = *(const u32x4*)(rQ + row * 1536 + cq); lC[mm] = *(const u32x4*)(rG + row * 1024 + cy); } }
#pragma unroll
                for (int mm = 0; mm < 2; ++mm) { const int m = mb + mm; const size_t roww = (size_t)(row0 + ai * HALF + m * 16) & rmask;
                    f32x4 v0 = acc[ai][bj][m][0] + b0, v1 = acc[ai][bj][m][1] + b1, s0, s1;
#pragma unroll
                    for (int i = 0; i < 4; ++i) { s0[i] = sigmoidf_(v0[i]); s1[i] = sigmoidf_(v1[i]); }
                    if (sub == 0) { s0 = s0 * v0; s1 = s1 * v1; }
                    f32x4 p0, p1; unpack8bf(lA[mm], p0, p1);
                    if (sub == 0 || sub == 2) *(u32x4*)(wG + roww * 1024 + cy) = pack8bf(p0 * s0, p1 * s1);
                    else if (sub == 1) *(u32x4*)(wQ + roww * 1536 + cq) = pack8bf(p0 * s0, p1 * s1);
                    else { f32x4 a0, a1, g0, g1; unpack8bf(lB[mm], a0, a1); unpack8bf(lC[mm], g0, g1); *(u32x4*)(wY + roww * 1024 + cy) = pack8bf(p0 * s0 + a0 + g0, p1 * s1 + a1 + g1); } }
                asm volatile("" ::: "memory"); } }
    }
};
struct EpiResF32 {
    static constexpr bool PERM = false, AFTER_DRAIN = false;
    const float* base; float* out; int ldc; unsigned rmask;
    __device__ __forceinline__ void operator()(const f32x4 (&acc)[2][2][4][2], const Unit& u, int wr, int wc, int fr, int fq) const {
        const int row0 = u.pm * BM + wr * 64 + fr, col0 = u.pn * BM + wc * 32 + 4 * fq;
#pragma unroll
        for (int ai = 0; ai < 2; ++ai)
#pragma unroll
            for (int m = 0; m < 4; ++m) { const size_t off = (size_t)(row0 + ai * HALF + m * 16) * ldc + col0, offw = (size_t)((row0 + ai * HALF + m * 16) & rmask) * ldc + col0;
#pragma unroll
                for (int bj = 0; bj < 2; ++bj)
#pragma unroll
                    for (int n = 0; n < 2; ++n) { const f32x4 bs = *(const f32x4*)(base + off + bj * HALF + n * 16); *(f32x4*)(out + offw + bj * HALF + n * 16) = bs + acc[ai][bj][m][n]; } }
    }
};
struct EpiRelu2 {
    static constexpr bool PERM = true, AFTER_DRAIN = false;
    bf16_t* O; int ldc;
    __device__ __forceinline__ void operator()(const f32x4 (&acc)[2][2][4][2], const Unit& u, int wr, int wc, int fr, int fq) const {
        const int row0 = u.pm * BM + wr * 64 + fr, col0 = u.pn * BM + wc * 32 + 8 * fq;
#pragma unroll
        for (int ai = 0; ai < 2; ++ai)
#pragma unroll
            for (int m = 0; m < 4; ++m) { bf16_t* rowp = O + (size_t)(row0 + ai * HALF + m * 16) * ldc + col0;
#pragma unroll
                for (int bj = 0; bj < 2; ++bj) { f32x4 v0 = acc[ai][bj][m][0], v1 = acc[ai][bj][m][1];
#pragma unroll
                    for (int i = 0; i < 4; ++i) { const float a = fmaxf(v0[i], 0.f), b = fmaxf(v1[i], 0.f); v0[i] = a * a; v1[i] = b * b; }
                    *(u32x4*)(rowp + bj * HALF) = pack8bf(v0, v1); } }
    }
};
struct ProjOrder : StaticOrder {
    __device__ bool next(int i, Unit& u) const { const long L = (long)i * G + c; if (L < nwg) return StaticOrder::next(i, u); const int r = (int)(L - nwg); if (r >= 10) return false; u.pm = 64 + r / 5; u.pn = 33 + r % 5; return true; }
};
struct MergeOrder : StaticOrder {
    __device__ bool next(int i, Unit& u) const { if (i >= 4) return false; Unit t; if (!StaticOrder::next(0, t)) return false; u.pm = t.pm; u.pn = 17 + 4 * i + t.pn; return true; }
};
template <class Epi, class Sched, bool ALIGN_EPI = false, bool SP2 = false>
__device__ __forceinline__ void gemm_phase(PG8_LAS unsigned char* lds, const Gemm g, const Sched& S, const Epi& E) {
    const int tid = threadIdx.x, wid = __builtin_amdgcn_readfirstlane(tid >> 6), lane = tid & 63, wr = wid >> 2, wc = wid & 3, fr = lane & 15, fq = lane >> 4;
    const int K = g.K, nt = K / BK;
    unsigned voffA[2], voffB[2];
#pragma unroll
    for (int i = 0; i < 2; ++i) { int R, C; stage_rc(tid * 16 + i * 8192, R, C); const int Rb = Epi::PERM ? ((R & ~31) + perm32(R & 31)) : R;
        voffA[i] = (unsigned)(R * K + C) * 2u; voffB[i] = (unsigned)(Rb * K + C) * 2u; }
    const size_t kstep = (size_t)(BK * 2);
    const size_t hstep = (size_t)HALF * K * 2;
    const size_t tstep = 2 * hstep;
    const unsigned ldsw = (unsigned)wid * 1024u;
    const int aoff = lds_byte(wr * 64 + fr, fq * 8), boff = lds_byte(wc * 32 + fr, fq * 8);
#define PG8_SA(b, h) (((b) * 2 + (h)) * HTB)
#define PG8_SB(b, h) ((4 + (b) * 2 + (h)) * HTB)
#define PG8_STAGE(bufoff, gbase, voff) do { _Pragma("unroll") for (int _i = 0; _i < 2; ++_i) \
        __builtin_amdgcn_global_load_lds((const unsigned*)((const char*)(gbase) + (voff)[_i]), (PG8_LAS unsigned*)(lds + (bufoff) + ldsw + _i * 8192), 16, 0, 0); } while (0)
#define PG8_LDA(dst, b, h) do { _Pragma("unroll") for (int m = 0; m < 4; ++m) _Pragma("unroll") for (int k = 0; k < 2; ++k) dst[m][k] = *(const PG8_LAS bf16x8*)(lds + PG8_SA(b, h) + aoff + m * 2048 + k * 1024); } while (0)
#define PG8_LDB(dst, b, h) do { _Pragma("unroll") for (int n = 0; n < 2; ++n) _Pragma("unroll") for (int k = 0; k < 2; ++k) dst[n][k] = *(const PG8_LAS bf16x8*)(lds + PG8_SB(b, h) + boff + n * 2048 + k * 1024); } while (0)
#define PG8_MMA(ai, bj, At, Bt) do { __builtin_amdgcn_s_setprio(1); _Pragma("unroll") for (int m = 0; m < 4; ++m) _Pragma("unroll") for (int n = 0; n < 2; ++n) _Pragma("unroll") for (int k = 0; k < 2; ++k) \
        acc[ai][bj][m][n] = __builtin_amdgcn_mfma_f32_16x16x32_bf16(Bt[n][k], At[m][k], acc[ai][bj][m][n], 0, 0, 0); __builtin_amdgcn_s_setprio(0); } while (0)
#define PG8_WAIT_V(n) asm volatile("s_waitcnt vmcnt(" #n ")" ::: "memory")
#define PG8_WAIT_L(n) asm volatile("s_waitcnt lgkmcnt(" #n ")" ::: "memory")
#define PG8_BAR __builtin_amdgcn_s_barrier()
#define PG8_SCHED __builtin_amdgcn_sched_barrier(0)
    Unit cur, nxt; int ui = 0;
    if (!S.next(0, cur)) return;
    f32x4 acc[2][2][4][2];
#pragma unroll
    for (int a = 0; a < 2; ++a)
#pragma unroll
        for (int b = 0; b < 2; ++b)
#pragma unroll
            for (int m = 0; m < 4; ++m)
#pragma unroll
                for (int n = 0; n < 2; ++n) acc[a][b][m][n] = (f32x4){0.f, 0.f, 0.f, 0.f};
    bf16x8 At[4][2], B0[2][2], B1[2][2];
    const char* cA = (const char*)g.A + (size_t)cur.pm * tstep; const char* cB = (const char*)g.Bt + (size_t)cur.pn * tstep;
    S.a_ready(cur);
    if constexpr (SP2) {
        PG8_STAGE(PG8_SB(0, 0), cB, voffB); PG8_STAGE(PG8_SB(0, 1), cB + hstep, voffB); PG8_STAGE(PG8_SA(0, 0), cA, voffA); PG8_STAGE(PG8_SA(0, 1), cA + hstep, voffA);
        if (wr == 1) PG8_BAR;
        PG8_WAIT_V(2); PG8_BAR;
        PG8_STAGE(PG8_SB(1, 0), cB + kstep, voffB); PG8_STAGE(PG8_SA(1, 0), cA + kstep, voffA); PG8_STAGE(PG8_SB(1, 1), cB + hstep + kstep, voffB);
        PG8_WAIT_V(6); PG8_BAR;
    } else {
        PG8_STAGE(PG8_SB(0, 0), cB, voffB); PG8_STAGE(PG8_SA(0, 0), cA, voffA); PG8_STAGE(PG8_SB(0, 1), cB + hstep, voffB); PG8_STAGE(PG8_SA(0, 1), cA + hstep, voffA);
        if (wr == 1) PG8_BAR;
        PG8_WAIT_V(4); PG8_BAR;
        PG8_STAGE(PG8_SB(1, 0), cB + kstep, voffB); PG8_STAGE(PG8_SA(1, 0), cA + kstep, voffA); PG8_STAGE(PG8_SB(1, 1), cB + hstep + kstep, voffB);
        PG8_WAIT_V(6); PG8_BAR;
    }
    for (;;) {
        const bool has_next = S.next(ui + 1, nxt);
        const char* nA = has_next ? (const char*)g.A + (size_t)nxt.pm * tstep : cA; const char* nB = has_next ? (const char*)g.Bt + (size_t)nxt.pn * tstep : cB;
        for (int t = 0; t < nt; t += 2) {
            const bool last = (t == nt - 2);
            const char* a1 = cA + (size_t)(t + 1) * kstep;
            const char* a2 = last ? nA : cA + (size_t)(t + 2) * kstep; const char* b2 = last ? nB : cB + (size_t)(t + 2) * kstep;
            const char* a3 = a2 + kstep; const char* b3 = b2 + kstep;
            if (last && has_next) S.a_ready(nxt);
            if constexpr (SP2) {
            PG8_LDB(B0, 0, 0); PG8_LDB(B1, 0, 1); PG8_SCHED; PG8_LDA(At, 0, 0); PG8_STAGE(PG8_SA(1, 1), a1 + hstep, voffA);
            PG8_WAIT_V(8); PG8_WAIT_L(0); PG8_BAR; PG8_MMA(0, 0, At, B0); PG8_MMA(0, 1, At, B1); PG8_BAR; PG8_SCHED;
            PG8_LDA(At, 0, 1); PG8_STAGE(PG8_SB(0, 0), b2, voffB); PG8_STAGE(PG8_SB(0, 1), b2 + hstep, voffB); PG8_STAGE(PG8_SA(0, 0), a2, voffA);
            PG8_WAIT_V(8); PG8_WAIT_L(0); PG8_BAR; PG8_MMA(1, 0, At, B0); PG8_MMA(1, 1, At, B1); PG8_BAR; PG8_SCHED;
            PG8_LDB(B0, 1, 0); PG8_LDB(B1, 1, 1); PG8_SCHED; PG8_LDA(At, 1, 0); PG8_STAGE(PG8_SA(0, 1), a2 + hstep, voffA);
            PG8_WAIT_V(8); PG8_WAIT_L(0); PG8_BAR; PG8_MMA(0, 0, At, B0); PG8_MMA(0, 1, At, B1); PG8_BAR; PG8_SCHED;
            PG8_LDA(At, 1, 1); PG8_STAGE(PG8_SB(1, 0), b3, voffB); PG8_STAGE(PG8_SB(1, 1), b3 + hstep, voffB); PG8_STAGE(PG8_SA(1, 0), a3, voffA);
            PG8_WAIT_V(8); PG8_WAIT_L(0); PG8_BAR; PG8_MMA(1, 0, At, B0); PG8_MMA(1, 1, At, B1); PG8_BAR; PG8_SCHED;
            } else {
            PG8_LDB(B0, 0, 0); PG8_SCHED; PG8_LDA(At, 0, 0); PG8_STAGE(PG8_SA(1, 1), a1 + hstep, voffA);
            PG8_WAIT_L(8); PG8_BAR; PG8_WAIT_L(0); PG8_MMA(0, 0, At, B0); PG8_BAR; PG8_SCHED;
            PG8_LDB(B1, 0, 1); PG8_STAGE(PG8_SB(0, 0), b2, voffB);
            PG8_BAR; PG8_WAIT_L(0); PG8_MMA(0, 1, At, B1); PG8_BAR;
            PG8_LDA(At, 0, 1); PG8_STAGE(PG8_SA(0, 0), a2, voffA);
            PG8_BAR; PG8_WAIT_L(0); PG8_MMA(1, 0, At, B0); PG8_BAR; PG8_SCHED;
            PG8_STAGE(PG8_SB(0, 1), b2 + hstep, voffB);
            PG8_WAIT_V(6); PG8_BAR; PG8_MMA(1, 1, At, B1); PG8_BAR;
            PG8_LDB(B0, 1, 0); PG8_SCHED; PG8_LDA(At, 1, 0); PG8_STAGE(PG8_SA(0, 1), a2 + hstep, voffA);
            PG8_WAIT_L(8); PG8_BAR; PG8_WAIT_L(0); PG8_MMA(0, 0, At, B0); PG8_BAR; PG8_SCHED;
            PG8_LDB(B1, 1, 1); PG8_STAGE(PG8_SB(1, 0), b3, voffB);
            PG8_BAR; PG8_WAIT_L(0); PG8_MMA(0, 1, At, B1); PG8_BAR;
            PG8_LDA(At, 1, 1); PG8_STAGE(PG8_SA(1, 0), a3, voffA);
            PG8_BAR; PG8_WAIT_L(0); PG8_MMA(1, 0, At, B0); PG8_BAR; PG8_SCHED;
            PG8_STAGE(PG8_SB(1, 1), b3 + hstep, voffB);
            PG8_WAIT_V(6); PG8_BAR; PG8_MMA(1, 1, At, B1); PG8_BAR;
            }
        }
        if constexpr (ALIGN_EPI) { if (wr == 0) PG8_BAR; }
        if constexpr (!Epi::AFTER_DRAIN) { E(acc, cur, wr, wc, fr, fq); S.done(cur); }
        if (!has_next) break;
#pragma unroll
        for (int a = 0; a < 2; ++a)
#pragma unroll
            for (int b = 0; b < 2; ++b)
#pragma unroll
                for (int m = 0; m < 4; ++m)
#pragma unroll
                    for (int n = 0; n < 2; ++n) acc[a][b][m][n] = (f32x4){0.f, 0.f, 0.f, 0.f};
        cur = nxt; cA = nA; cB = nB; ++ui;
        if constexpr (ALIGN_EPI) { if (wr == 1) PG8_BAR; }
    }
    PG8_WAIT_V(0);
    if constexpr (!ALIGN_EPI) { if (wr == 0) PG8_BAR; }
    PG8_BAR;
    if constexpr (Epi::AFTER_DRAIN) { E.fused(acc, cur, wr, wc, fr, fq, lds, wid, lane); S.done(cur); }
#undef PG8_SA
#undef PG8_SB
#undef PG8_STAGE
#undef PG8_LDA
#undef PG8_LDB
#undef PG8_MMA
#undef PG8_WAIT_V
#undef PG8_WAIT_L
#undef PG8_BAR
#undef PG8_SCHED
}
}
namespace att {
typedef short bf16x8 __attribute__((ext_vector_type(8)));
typedef short s16x4 __attribute__((ext_vector_type(4)));
typedef float f32x16 __attribute__((ext_vector_type(16)));
typedef float f32x4 __attribute__((ext_vector_type(4)));
typedef unsigned u32x4 __attribute__((ext_vector_type(4)));
#define ATT_SBAR() __builtin_amdgcn_sched_barrier(0)
__device__ __forceinline__ int v_st(int k, int c) { const int kk = (k & ~0xC) | ((k & 4) << 1) | ((k & 8) >> 1); return ((kk >> 3) * 4 + (c >> 5)) * 512 + ((kk & 7) * 32 + (c & 31)) * 2; }
__device__ __forceinline__ int v_rd_base(int lane) { return ((lane & 3) << 3) | (((lane >> 2) & 3) << 6) | (((lane >> 4) & 1) << 5) | (((lane >> 5) & 1) << 8); }
constexpr int v_rd_off(int d0, int ks, int half) { return d0 * 512 + ks * 4096 + half * 2048; }
__device__ __forceinline__ int crow(int r, int hi) { return (r & 3) + 8 * (r >> 2) + 4 * hi; }
__device__ __forceinline__ unsigned cvtpk(float lo, float hi) { unsigned r; asm volatile("v_cvt_pk_bf16_f32 %0, %1, %2" : "=v"(r) : "v"(lo), "v"(hi)); return r; }
__device__ __forceinline__ bf16x8 pack8(f32x4 a, f32x4 b) { u32x4 w = {cvtpk(a[0], a[1]), cvtpk(a[2], a[3]), cvtpk(b[0], b[1]), cvtpk(b[2], b[3])}; return __builtin_bit_cast(bf16x8, w); }
constexpr float THRL = 8.0f;
__device__ __forceinline__ void mask_tile(f32x16& p0, f32x16& p1, int dq) {
    const float NEG = -__builtin_inff();
#pragma unroll
    for (int r = 0; r < 16; ++r) { const int c = (r & 3) + 8 * (r >> 2); if (dq - c < 0) p0[r] = NEG; if (dq - c - 32 < 0) p1[r] = NEG; }
}
__device__ __forceinline__ void softmax_tile(f32x16& p0, f32x16& p1, float& m_reg, float& l_reg, float& alpha, bf16x8& pa0, bf16x8& pa1, bf16x8& pa2, bf16x8& pa3) {
    float pmax = p0[0];
#pragma unroll
    for (int r = 1; r < 16; ++r) pmax = fmaxf(pmax, p0[r]);
#pragma unroll
    for (int r = 0; r < 16; ++r) pmax = fmaxf(pmax, p1[r]);
    { auto rr = __builtin_amdgcn_permlane32_swap(__float_as_uint(pmax), __float_as_uint(pmax), false, false); pmax = fmaxf(__uint_as_float(rr[0]), __uint_as_float(rr[1])); }
    float mn;
    if (__builtin_expect(__all(pmax - m_reg <= THRL), 1)) { mn = m_reg; alpha = 1.f; }
    else { mn = fmaxf(m_reg, pmax); alpha = __builtin_amdgcn_exp2f(m_reg - mn); m_reg = mn; }
#pragma unroll
    for (int r = 0; r < 16; ++r) { p0[r] = __builtin_amdgcn_exp2f(p0[r] - mn); p1[r] = __builtin_amdgcn_exp2f(p1[r] - mn); }
    float ps = 0.f;
#pragma unroll
    for (int r = 0; r < 16; ++r) ps += p0[r];
#pragma unroll
    for (int r = 0; r < 16; ++r) ps += p1[r];
    { auto rr = __builtin_amdgcn_permlane32_swap(__float_as_uint(ps), __float_as_uint(ps), false, false); ps = __uint_as_float(rr[0]) + __uint_as_float(rr[1]); }
    l_reg = l_reg * alpha + ps;
#define ATT_PK4(P, B_, OUT) do { unsigned a0 = cvtpk(P[B_+0], P[B_+1]), a1 = cvtpk(P[B_+2], P[B_+3]); unsigned b0 = cvtpk(P[B_+4], P[B_+5]), b1 = cvtpk(P[B_+6], P[B_+7]); \
        auto r0 = __builtin_amdgcn_permlane32_swap(a0, b0, false, false); auto r1 = __builtin_amdgcn_permlane32_swap(a1, b1, false, false); \
        u32x4 w = {r0[0], r1[0], r0[1], r1[1]}; OUT = __builtin_bit_cast(bf16x8, w); } while (0)
    ATT_PK4(p0, 0, pa0); ATT_PK4(p0, 8, pa1); ATT_PK4(p1, 0, pa2); ATT_PK4(p1, 8, pa3);
#undef ATT_PK4
}
template <int DQK> __device__ __forceinline__ void qkt(f32x16& p0, f32x16& p1, const PG8_LAS char* Kb, int r32, int hi, const bf16x8* qr) {
    constexpr int KSTR = DQK * 2 + 16;
    p0 = f32x16{}; p1 = f32x16{};
    const PG8_LAS char* a = Kb + r32 * KSTR + hi * 16;
#pragma unroll
    for (int d0 = 0; d0 < DQK / 16; ++d0) {
        const bf16x8 b0 = *(const PG8_LAS bf16x8*)(a + d0 * 32), b1 = *(const PG8_LAS bf16x8*)(a + d0 * 32 + 32 * KSTR);
        p0 = __builtin_amdgcn_mfma_f32_32x32x16_bf16(b0, qr[d0], p0, 0, 0, 0);
        p1 = __builtin_amdgcn_mfma_f32_32x32x16_bf16(b1, qr[d0], p1, 0, 0, 0); }
}
__device__ __forceinline__ void pv_block(f32x16* o, int vb0, bf16x8 pa0, bf16x8 pa1, bf16x8 pa2, bf16x8 pa3) {
#define ATT_TRRD(dst, off) asm volatile("ds_read_b64_tr_b16 %0, %1 offset:%2" : "=&v"(dst) : "v"(vb0), "i"(off) : "memory")
#define ATT_PV_D0(d0) do { s16x4 l0, l1, l2, l3, h0, h1, h2, h3; constexpr int b_ = v_rd_off(d0, 0, 0); \
        ATT_TRRD(l0, b_); ATT_TRRD(h0, b_ + 2048); ATT_TRRD(l1, b_ + 4096); ATT_TRRD(h1, b_ + 6144); ATT_TRRD(l2, b_ + 8192); ATT_TRRD(h2, b_ + 10240); ATT_TRRD(l3, b_ + 12288); ATT_TRRD(h3, b_ + 14336); \
        asm volatile("s_waitcnt lgkmcnt(0)" ::: "memory"); ATT_SBAR(); \
        o[d0] = __builtin_amdgcn_mfma_f32_32x32x16_bf16(pa0, (bf16x8){l0[0], l0[1], l0[2], l0[3], h0[0], h0[1], h0[2], h0[3]}, o[d0], 0, 0, 0); \
        o[d0] = __builtin_amdgcn_mfma_f32_32x32x16_bf16(pa1, (bf16x8){l1[0], l1[1], l1[2], l1[3], h1[0], h1[1], h1[2], h1[3]}, o[d0], 0, 0, 0); \
        o[d0] = __builtin_amdgcn_mfma_f32_32x32x16_bf16(pa2, (bf16x8){l2[0], l2[1], l2[2], l2[3], h2[0], h2[1], h2[2], h2[3]}, o[d0], 0, 0, 0); \
        o[d0] = __builtin_amdgcn_mfma_f32_32x32x16_bf16(pa3, (bf16x8){l3[0], l3[1], l3[2], l3[3], h3[0], h3[1], h3[2], h3[3]}, o[d0], 0, 0, 0); } while (0)
    ATT_PV_D0(0); ATT_PV_D0(1); ATT_PV_D0(2); ATT_PV_D0(3);
#undef ATT_PV_D0
#undef ATT_TRRD
}
template <int DQK, int DV, bool CAUSAL, bool PREF, class Src>
__device__ __forceinline__ void attn_unit(PG8_LAS char* lds, const bf16x8* qr, const int NT, const int qrel  , const Src& S) {
    constexpr int KSTR = DQK * 2 + 16, KT = 64 * KSTR, NVB = DV / 128, VT = NVB * 16384, NKC = DQK / 64, NVC = NVB * 2;
    constexpr int OFF_K = 0, OFF_V = 2 * KT, OFF_WS = 2 * KT + 2 * VT;
    const int tid = threadIdx.x, wid = __builtin_amdgcn_readfirstlane(tid >> 6), lane = tid & 63, r32 = lane & 31, hi = lane >> 5;
    PG8_LAS float* al_l = (PG8_LAS float*)(lds + OFF_WS) + wid * 64; PG8_LAS float* li_l = al_l + 32;
    const int vb0 = (int)(unsigned)(uintptr_t)(lds + OFF_V) + v_rd_base(lane);
    float m_reg = -1e30f, l_reg = 0.f; f32x16 o[NVB * 4];
#pragma unroll
    for (int i = 0; i < NVB * 4; ++i) o[i] = f32x16{};
    u32x4 sk[NKC], sv[NVC];
#define ATT_WRITE(bf) S.write(lds + OFF_K + (bf) * KT, lds + OFF_V + (bf) * VT, sk, sv)
    S.load(0, sk, sv); ATT_WRITE(0);
    __syncthreads();
#define ATT_STEP(BUF, t) do { \
        if (PREF && (t) + 1 < NT) S.load((t) + 1, sk, sv); \
        f32x16 p0, p1; float alpha; bf16x8 pa0, pa1, pa2, pa3; \
        ATT_SBAR(); qkt<DQK>(p0, p1, lds + OFF_K + (BUF) * KT, r32, hi, qr); \
        if (CAUSAL && (t) >= NT - 4) { const int jb = (t) - (NT - 4); if (64 * jb + 63 > qrel) mask_tile(p0, p1, qrel + r32 - 4 * hi - 64 * jb); } \
        softmax_tile(p0, p1, m_reg, l_reg, alpha, pa0, pa1, pa2, pa3); \
        if (__any(alpha < 1.f)) { if (hi == 0) al_l[r32] = alpha; asm volatile("s_waitcnt lgkmcnt(0)" ::: "memory"); \
            _Pragma("unroll") for (int d_ = 0; d_ < NVB * 4; ++d_) _Pragma("unroll") for (int r = 0; r < 16; ++r) o[d_][r] *= al_l[crow(r, hi)]; } \
        ATT_SBAR(); \
        _Pragma("unroll") for (int vb = 0; vb < NVB; ++vb) pv_block(o + 4 * vb, vb0 + (BUF) * VT + vb * 16384, pa0, pa1, pa2, pa3); \
        if ((t) + 1 < NT) { if (!PREF) S.load((t) + 1, sk, sv); ATT_WRITE((BUF) ^ 1); } \
        __syncthreads(); } while (0)
    for (int t = 0; t < NT; t += 2) { ATT_STEP(0, t); ATT_STEP(1, t + 1); }
#undef ATT_STEP
#undef ATT_WRITE
    if (hi == 0) li_l[r32] = l_reg;
    asm volatile("s_waitcnt lgkmcnt(0)" ::: "memory");
#pragma unroll
    for (int r = 0; r < 16; ++r) { const float rl = __builtin_amdgcn_rcpf(li_l[crow(r, hi)]); const int orow = crow(r, hi);
#pragma unroll
        for (int d = 0; d < NVB * 4; ++d) { const float v = o[d][r] * rl; const float vn = __shfl_xor(v, 1); if ((r32 & 1) == 0) S.store(orow, d * 32 + r32, v, vn); } }
    __syncthreads();
}
#undef ATT_SBAR
}
constexpr int NWAVES = 8;
#ifndef MK_N_LAUNCHES
#define MK_N_LAUNCHES 1
#endif
constexpr int PER_PHASE = 13;
constexpr int N_LAUNCHES = MK_N_LAUNCHES;

constexpr int BATCH = 2, SEQ = 8192, D = 1024, M = BATCH * SEQ, MEM_LEN = 256, MROWS = BATCH * MEM_LEN;
constexpr int D_IN = 8272, FF = 4096;
constexpr int NP1 = 17 * 256;
constexpr int NPAD = 33 * 256;
constexpr float EPS = 1e-6f;
constexpr float QK_SCALE_L2 = 0.07216878364870322f * 1.4426950408889634f;
constexpr float MEM_SCALE_L2 = 0.125f * 1.4426950408889634f;
constexpr int GC = 128, GNC = SEQ / GC;

constexpr size_t MiB = 1u << 20;
constexpr size_t WS_CTL = 0, CTL_ZERO_BYTES = 1 * MiB;
constexpr size_t WS_WIN = 1 * MiB;
constexpr size_t WS_WUKV = 20 * MiB;
constexpr size_t WS_WO = 21 * MiB;
constexpr size_t WS_WUP = 23 * MiB;
constexpr size_t WS_WDN = 31 * MiB;
constexpr size_t WS_XN = 39 * MiB;
constexpr size_t WS_Q = 72 * MiB;
constexpr size_t WS_GQ = 120 * MiB, WS_GK = 136 * MiB, WS_GV = 152 * MiB;
constexpr size_t WS_CKV = 184 * MiB, WS_QMEM = 192 * MiB, WS_KRAG = 200 * MiB, WS_KVM = 204 * MiB;
constexpr size_t WS_ST = 206 * MiB;
constexpr size_t WS_KPE = 238 * MiB;
constexpr size_t WS_ROPE = 240 * MiB;
constexpr size_t WS_DEC = 244 * MiB;
constexpr size_t WS_H = 72 * MiB;
constexpr size_t WS_END = 256 * MiB;
constexpr int CW_TMO = 0, CW_CODE = 1, CW_BAR = 4096;

constexpr int RING_OFF = 0, RING_BYTES = 131072;
constexpr int PHASE_BYTES = 139264;
constexpr int EXCH_OFF = 139264;
constexpr int LDSCTL_OFF = 147456, MISC_OFF = LDSCTL_OFF + 320;
constexpr int LDS_BYTES = 148480;

#define GAS __attribute__((address_space(1)))
#define LAS __attribute__((address_space(3)))
typedef unsigned short bf16;
typedef unsigned v4u __attribute__((ext_vector_type(4)));
typedef float f32x4 __attribute__((ext_vector_type(4)));
typedef short bf16x8 __attribute__((ext_vector_type(8)));
typedef GAS unsigned gu32;
typedef GAS unsigned long long gu64;
#define RLX_AGENT __ATOMIC_RELAXED, __HIP_MEMORY_SCOPE_AGENT
#define LDS_WAIT() asm volatile("s_waitcnt lgkmcnt(0)" ::: "memory")
#define VM_WAIT() asm volatile("s_waitcnt vmcnt(0)" ::: "memory")
__device__ __forceinline__ unsigned long long rt() { return __builtin_amdgcn_s_memrealtime(); }
__device__ __forceinline__ unsigned f2bf(float f) { unsigned u = __builtin_bit_cast(unsigned, f); return (u + 0x7fffu + ((u >> 16) & 1u)) >> 16; }
__device__ __forceinline__ unsigned pk2(float lo, float hi) { return f2bf(lo) | (f2bf(hi) << 16); }
#define XB_TMO      128
#define XB_XCNT(j)  (256  + 64 * (j))
#define XB_XSUB(j)  (1280 + 64 * (j))
#define XB_XGEN(j)  (2304 + 64 * (j))
#define XB_TOP      3328
#define XB_TOPGEN   3392
#define XCD_BAR_WORDS 3456
#define XB_SPIN_CAP (1u << 18)

__device__ __forceinline__ unsigned xb_ld(unsigned* p)              { return __hip_atomic_load(p, __ATOMIC_RELAXED, __HIP_MEMORY_SCOPE_AGENT); }
__device__ __forceinline__ unsigned xb_add(unsigned* p, unsigned v) { return __hip_atomic_fetch_add(p, v, __ATOMIC_RELAXED, __HIP_MEMORY_SCOPE_AGENT); }
__device__ __forceinline__ unsigned xb_xcc_id() { return (unsigned)__builtin_amdgcn_s_getreg((3 << 11) | 20) & 0xFu; }
#define XB_SPIN(cond, bar) do { unsigned _sp = 0; while (cond) { __builtin_amdgcn_s_sleep(1); \
    if ((++_sp & 255u) == 0u) { if (xb_ld(&(bar)[XB_TMO])) break; if (_sp > XB_SPIN_CAP) { atomicAdd(&(bar)[XB_TMO], 1u); break; } } } } while (0)

struct XcdBarrier {
    unsigned* bar; unsigned x;
    volatile LAS unsigned* st;
};

__device__ __forceinline__ XcdBarrier xcd_barrier_post(unsigned* bar, volatile LAS unsigned* st) {
    XcdBarrier b; b.bar = bar; b.x = xb_xcc_id(); b.st = st;
    if (threadIdx.x == 0) (void)xb_add(&bar[XB_XCNT(b.x)], 1u);
    return b;
}
__device__ __forceinline__ void xcd_barrier_complete(unsigned* bar, unsigned x, unsigned& nloc, unsigned& nx) {
    const unsigned G = gridDim.x * gridDim.y * gridDim.z;
    unsigned sum, cnt, mine, sp = 0u;
    for (;;) {
        sum = 0u; cnt = 0u; mine = 0u;
#pragma unroll
        for (unsigned j = 0; j < 16; ++j) { const unsigned c = xb_ld(&bar[XB_XCNT(j)]); sum += c; cnt += (c > 0u) ? 1u : 0u; mine = (j == x) ? c : mine; }
        if (sum == G) break;
        __builtin_amdgcn_s_sleep(1);
        if ((++sp & 255u) == 0u) { if (xb_ld(&bar[XB_TMO])) break; if (sp > XB_SPIN_CAP) { atomicAdd(&bar[XB_TMO], 1u); break; } }
    }
    nloc = mine > 0u ? mine : 1u; nx = cnt > 0u ? cnt : 1u;
}

__device__ __forceinline__ void xcd_barrier(const XcdBarrier& b) {
    asm volatile("s_waitcnt vmcnt(0)" ::: "memory");
    __syncthreads();
    if (threadIdx.x == 0) {
        unsigned* bar = b.bar;
        __builtin_amdgcn_s_waitcnt(0);
        unsigned nloc = b.st[0], nx = b.st[1];
        if (nloc == 0u) { xcd_barrier_complete(bar, b.x, nloc, nx); b.st[0] = nloc; b.st[1] = nx; }
        const unsigned old = xb_add(&bar[XB_XSUB(b.x)], 1u);
        const unsigned gen = old / nloc;
        if (old + 1u == (gen + 1u) * nloc) {
            __builtin_amdgcn_fence(__ATOMIC_RELEASE, "agent");
            asm volatile("s_waitcnt vmcnt(0)" ::: "memory");
            const unsigned og = xb_add(&bar[XB_TOP], 1u);
            const unsigned tg = og / nx;
            if (og + 1u == (tg + 1u) * nx) xb_add(&bar[XB_TOPGEN], 1u);
            else XB_SPIN(xb_ld(&bar[XB_TOPGEN]) == tg, bar);
            __builtin_amdgcn_fence(__ATOMIC_ACQUIRE, "agent");
            xb_add(&bar[XB_XGEN(b.x)], 1u);
            asm volatile("s_waitcnt vmcnt(0)" ::: "memory");
        } else {
            XB_SPIN(xb_ld(&bar[XB_XGEN(b.x)]) == gen, bar);
            __builtin_amdgcn_fence(__ATOMIC_ACQUIRE, "agent");
            asm volatile("s_waitcnt vmcnt(0)" ::: "memory");
        }
    }
    __syncthreads();
}

struct Frame {
    LAS unsigned char* lds;
    volatile LAS unsigned* MISC;
    gu32* ctl;
    int tid, lane, wave;
    int vcu, G;
    unsigned char* ws; float* out;
};
#define WSP(T, off) ((T*)(F.ws + (off)))

__device__ __forceinline__ float wave_sum(float v) {
#pragma unroll
    for (int o = 1; o < 64; o <<= 1) v += __shfl_xor(v, o);
    return v;
}
__device__ __forceinline__ void tr_item(const float* W, int ldw, int K, int col0, int ncols, bf16* WT, int row_off, LAS float* scr, int item, int lane, const float* kscale, float cscale) {
    const int nblk = (ncols + 31) / 32, kb = item / nblk, nb = item % nblk, k0 = 64 * kb, n0 = 32 * nb;
    const bool cv = (n0 + (lane & 31)) < ncols;
#pragma unroll 8
    for (int i = 0; i < 32; ++i) { const int kk = 2 * i + (lane >> 5); float v = cv ? W[(size_t)(k0 + kk) * ldw + col0 + n0 + (lane & 31)] : 0.f; v *= cscale; if (kscale) v *= kscale[k0 + kk]; scr[kk * 33 + (lane & 31)] = v; }
    LDS_WAIT(); asm volatile("" ::: "memory");
    const int c = lane & 7;
#pragma unroll
    for (int j = 0; j < 4; ++j) { const int n = (lane >> 3) + 8 * j; const LAS float* s = scr + (8 * c) * 33 + n;
        v4u o; o.x = pk2(s[0 * 33], s[1 * 33]); o.y = pk2(s[2 * 33], s[3 * 33]); o.z = pk2(s[4 * 33], s[5 * 33]); o.w = pk2(s[6 * 33], s[7 * 33]);
        *(GAS v4u*)(WT + (size_t)(row_off + n0 + n) * K + k0 + 8 * c) = o; }
    LDS_WAIT(); asm volatile("" ::: "memory");
}
__device__ __forceinline__ void rms_row_to_bf16(int lane, const float* xrow, const float* g, bf16* orow) {
    const GAS f32x4* xr = (const GAS f32x4*)xrow + lane; const GAS f32x4* gr = (const GAS f32x4*)g + lane;
    f32x4 v[4]; float s = 0.f;
#pragma unroll
    for (int j = 0; j < 4; ++j) { v[j] = xr[64 * j]; s += (v[j].x * v[j].x + v[j].y * v[j].y) + (v[j].z * v[j].z + v[j].w * v[j].w); }
    const float rstd = 1.f / sqrtf(wave_sum(s) * (1.f / D) + EPS);
    GAS unsigned long long* o8 = (GAS unsigned long long*)orow + lane;
#pragma unroll
    for (int j = 0; j < 4; ++j) { const f32x4 gg = gr[64 * j]; o8[64 * j] = (unsigned long long)pk2(v[j].x * rstd * gg.x, v[j].y * rstd * gg.y) | ((unsigned long long)pk2(v[j].z * rstd * gg.z, v[j].w * rstd * gg.w) << 32); }
}
struct RopeArg { double inv_rev[32]; };
struct P0In { const float *x, *mem; const int* pos; const float *g_mix, *w_in, *g_ckv, *w_ukv, *g_mem, *w_mem_kv, *w_o, *w_up, *w_down; };
__device__ __forceinline__ void p0_prologue(Frame& F, const P0In& I, const RopeArg& ra) {
    LAS float* scr = (LAS float*)(F.lds + RING_OFF + F.wave * 16384);
    const int gw = F.vcu * NWAVES + F.wave, NGW = F.G * NWAVES;
    bf16* Win_t = WSP(bf16, WS_WIN);
    {
#define SEG(W_, ldw_, K_, col0_, ncols_, WT_, roff_, ks_, cs_) { const int n_ = ((K_) / 64) * (((ncols_) + 31) / 32); if (r < n_) { tr_item(W_, ldw_, K_, col0_, ncols_, WT_, roff_, scr, r, F.lane, ks_, cs_); continue; } r -= n_; }
        constexpr int NIT = 16 * (48 + 8 + 2 + 1 + 16 + 16 + 32 + 8 + 32 + 96) + 16 * 40 + 4 * 64 + 16 * 32 + 16 * 128 + 64 * 32;
        for (int it = gw; it < NIT; it += NGW) { int r = it;
            SEG(I.w_in, D_IN, 1024, 0, 1536, Win_t, 0, nullptr, 1.f)
            SEG(I.w_in, D_IN, 1024, 1536, 256, Win_t, 1536, nullptr, 1.f)
            SEG(I.w_in, D_IN, 1024, 1792, 64, Win_t, 1792, nullptr, 1.f)
            SEG(I.w_in, D_IN, 1024, 3904, 16, Win_t, 1856, nullptr, 1.f)
            SEG(I.w_in, D_IN, 1024, 1856, 512, Win_t, 2048, nullptr, 0.08838834764831845f)
            SEG(I.w_in, D_IN, 1024, 2368, 512, Win_t, 2560, nullptr, 1.f)
            SEG(I.w_in, D_IN, 1024, 2880, 1024, Win_t, 3072, nullptr, 1.f)
            SEG(I.w_in, D_IN, 1024, 4944, 256, Win_t, 4096, nullptr, 1.f)
            SEG(I.w_in, D_IN, 1024, 3920, 1024, Win_t, 4352, nullptr, 1.f)
            SEG(I.w_in, D_IN, 1024, 5200, 3072, Win_t, 5376, nullptr, 1.f)
            SEG(I.w_mem_kv, 1280, 1024, 0, 1280, Win_t, NPAD, nullptr, 1.f)
            SEG(I.w_ukv, 2048, 256, 0, 2048, WSP(bf16, WS_WUKV), 0, I.g_ckv, 1.f)
            SEG(I.w_o, 1024, 1024, 0, 1024, WSP(bf16, WS_WO), 0, nullptr, 1.f)
            SEG(I.w_up, 4096, 1024, 0, 4096, WSP(bf16, WS_WUP), 0, nullptr, 1.f)
            SEG(I.w_down, 1024, 4096, 0, 1024, WSP(bf16, WS_WDN), 0, nullptr, 1.f)
        }
#undef SEG
    }
    { const int gt = F.vcu * 512 + F.tid, NGT = F.G * 512; v4u z = {0u, 0u, 0u, 0u};
      for (int i = gt; i < 160 * 128; i += NGT) *(GAS v4u*)(Win_t + (size_t)1888 * 1024 + (size_t)i * 8) = z; }
    bf16* XN = WSP(bf16, WS_XN);
    for (int m = gw; m < M + MROWS; m += NGW) { if (m < M) rms_row_to_bf16(F.lane, I.x + (size_t)m * D, I.g_mix, XN + (size_t)m * D); else rms_row_to_bf16(F.lane, I.mem + (size_t)(m - M) * D, I.g_mem, XN + (size_t)m * D); }
    { float* COS = WSP(float, WS_ROPE); float* SIN = COS + (size_t)M * 32; const int gt = F.vcu * 512 + F.tid, NGT = F.G * 512;
      for (int i = gt; i < M * 32; i += NGT) { const int m = i >> 5, k = i & 31; const double rev = (double)I.pos[m] * ra.inv_rev[k]; const float fr = (float)(rev - floor(rev));
          COS[i] = __builtin_amdgcn_cosf(fr); SIN[i] = __builtin_amdgcn_sinf(fr); } }
}

__device__ __forceinline__ void kpe_phase(Frame& F, const float* g_k_rope) {
    const bf16* KRAG = WSP(bf16, WS_KRAG); bf16* KPE = WSP(bf16, WS_KPE); const float* COS = WSP(float, WS_ROPE); const float* SIN = COS + (size_t)M * 32;
    const int hw = (F.vcu * 512 + F.tid) >> 5, NHW = F.G * 16, i = F.tid & 31;
    const float g1 = g_k_rope[i], g2 = g_k_rope[i + 32];
    for (int m = hw; m < M; m += NHW) {
        const float t1 = __uint_as_float((unsigned)KRAG[(size_t)m * 128 + i] << 16), t2 = __uint_as_float((unsigned)KRAG[(size_t)m * 128 + 32 + i] << 16);
        float s = t1 * t1 + t2 * t2;
#pragma unroll
        for (int o = 1; o < 32; o <<= 1) s += __shfl_xor(s, o);
        const float rs = __builtin_amdgcn_rsqf(s * (1.f / 64.f) + EPS), a = t1 * rs * g1, b = t2 * rs * g2, c = COS[(size_t)m * 32 + i], sn = SIN[(size_t)m * 32 + i];
        KPE[(size_t)m * 64 + i] = (bf16)f2bf(a * c - b * sn); KPE[(size_t)m * 64 + 32 + i] = (bf16)f2bf(a * sn + b * c);
    }
}

typedef float f32x16 __attribute__((ext_vector_type(16)));
constexpr int GSTR = 272;
__device__ __forceinline__ int crow_(int r, int hi) { return (r & 3) + 8 * (r >> 2) + 4 * hi; }
__device__ __forceinline__ void mm32(f32x16& acc, const LAS unsigned char* X, const LAS unsigned char* Y, int r32, int hi, int ks0, int ks1) {
    const LAS unsigned char* xa = X + r32 * GSTR + hi * 16; const LAS unsigned char* ya = Y + r32 * GSTR + hi * 16;
    for (int ks = ks0; ks < ks1; ++ks) { const bf16x8 a = *(const LAS bf16x8*)(xa + ks * 32), b = *(const LAS bf16x8*)(ya + ks * 32); acc = __builtin_amdgcn_mfma_f32_32x32x16_bf16(a, b, acc, 0, 0, 0); }
}
__device__ __forceinline__ float log_sigmoid_(float z) { return fminf(z, 0.f) - 0.6931471805599453f * __builtin_amdgcn_logf(1.f + __builtin_amdgcn_exp2f(-1.4426950408889634f * fabsf(z))); }
typedef short v4i16_t __attribute__((ext_vector_type(4)));
__device__ __forceinline__ bf16x8 trfrag(const LAS unsigned char* lb, int d0, int ks) {
    const v4i16_t l = __builtin_amdgcn_ds_read_tr16_b64_v4i16((LAS v4i16_t*)(lb + d0 * 512 + ks * 4096)), h = __builtin_amdgcn_ds_read_tr16_b64_v4i16((LAS v4i16_t*)(lb + d0 * 512 + ks * 4096 + 2048));
    return (bf16x8){l[0], l[1], l[2], l[3], h[0], h[1], h[2], h[3]};
}
__device__ __forceinline__ void gla_local_unit(Frame& F, int unit, const float* w_gla_gate, const float* b_gla_gate, int dummy = 0) {
    const int tid = F.tid, lane = F.lane, wave = F.wave, r32 = lane & 31, hi = lane >> 5;
    const int bh = unit / GNC, c = unit % GNC, b = bh >> 2, h = bh & 3; const size_t tok0 = (size_t)b * SEQ + (size_t)c * GC;
    LAS unsigned char* lds = F.lds;
    LAS float* BL = (LAS float*)lds;
    LAS unsigned char* VTL = lds;
    LAS unsigned char* KTL = lds + 65536;
    LAS float* CAR = (LAS float*)(lds + 98304);
    const bf16* KRAG = WSP(bf16, WS_KRAG); bf16* GQ = WSP(bf16, WS_GQ); bf16* GK = WSP(bf16, WS_GK); const bf16* GV = WSP(bf16, WS_GV);
    { const int db = wave & 3, th = wave >> 2, d = db * 32 + r32; f32x4 w0, w1;
#pragma unroll
      for (int j = 0; j < 4; ++j) { w0[j] = w_gla_gate[(8 * hi + j) * 512 + h * 128 + d]; w1[j] = w_gla_gate[(8 * hi + 4 + j) * 512 + h * 128 + d]; }
      const bf16x8 wf = att::pack8(w0, w1); const float bias = b_gla_gate[h * 128 + d]; float run = 0.f;
#pragma unroll
      for (int tb = 0; tb < 2; ++tb) { const int t0 = th * 64 + tb * 32;
          const bf16x8 af = __builtin_bit_cast(bf16x8, *(const GAS v4u*)(KRAG + (tok0 + t0 + r32) * 128 + 64 + 8 * hi));
          f32x16 z = f32x16{}; z = __builtin_amdgcn_mfma_f32_32x32x16_bf16(af, wf, z, 0, 0, 0);
          float sg[4], psg[4];
#pragma unroll
          for (int g = 0; g < 4; ++g) { float cs = 0.f;
#pragma unroll
              for (int q = 0; q < 4; ++q) { cs += log_sigmoid_(z[4 * g + q] + bias) * (1.f / 16.f); z[4 * g + q] = cs; }
              sg[g] = cs; psg[g] = __shfl_xor(cs, 32); }
          float off = run;
#pragma unroll
          for (int g = 0; g < 4; ++g) { const float o_ = off + (hi ? psg[g] : 0.f);
#pragma unroll
              for (int q = 0; q < 4; ++q) BL[(t0 + 8 * g + 4 * hi + q) * 128 + d] = z[4 * g + q] + o_;
              off += sg[g] + psg[g]; }
          run = off; }
      if (hi == 0) CAR[th * 128 + d] = run;
    }
    __syncthreads();
#pragma unroll 2
    for (int j = 0; j < 4; ++j) { const int it = tid + 512 * j, t = it >> 4, ch = it & 15; const size_t go = (tok0 + t) * 512 + h * 128 + ch * 8;
        f32x4 b0 = *(const LAS f32x4*)(BL + t * 128 + ch * 8), b1 = *(const LAS f32x4*)(BL + t * 128 + ch * 8 + 4);
        if (t >= 64) { b0 = b0 + *(const LAS f32x4*)(CAR + ch * 8); b1 = b1 + *(const LAS f32x4*)(CAR + ch * 8 + 4); }
        f32x4 k0, k1, q0, q1; pg8::unpack8bf(*(const GAS v4u*)(GK + go), k0, k1); pg8::unpack8bf(*(const GAS v4u*)(GQ + go), q0, q1);
#pragma unroll
        for (int i = 0; i < 4; ++i) { const float e0 = __builtin_amdgcn_exp2f(1.4426950408889634f * b0[i]), e1 = __builtin_amdgcn_exp2f(1.4426950408889634f * b1[i]); q0[i] *= e0; q1[i] *= e1; k0[i] *= __builtin_amdgcn_rcpf(e0); k1[i] *= __builtin_amdgcn_rcpf(e1); }
        const v4u kw = pg8::pack8bf(k0, k1); { const size_t gw_ = dummy ? (go & 0xfffff) : go; bf16* GKw = dummy ? WSP(bf16, 245 * MiB) : GK; bf16* GQw = dummy ? WSP(bf16, 249 * MiB) : GQ; *(GAS v4u*)(GKw + gw_) = kw; *(GAS v4u*)(GQw + gw_) = pg8::pack8bf(q0, q1); }
        *(LAS v4u*)(KTL + (t >> 6) * 16384 + att::v_st(t & 63, ch * 8)) = kw; }
    __syncthreads();
#pragma unroll 2
    for (int j = 0; j < 8; ++j) { const int it = tid + 512 * j, t = it >> 5, ch = it & 31;
        *(LAS v4u*)(VTL + ((t >> 6) * 2 + (ch >> 4)) * 16384 + att::v_st(t & 63, (ch & 15) * 8)) = *(const GAS v4u*)(GV + (tok0 + t) * 1024 + h * 256 + ch * 8); }
    __syncthreads();
    { const int db = wave & 3, eb = wave >> 2; const int lb = att::v_rd_base(lane); f32x16 acc[4];
#pragma unroll
      for (int j = 0; j < 4; ++j) acc[j] = f32x16{};
#pragma unroll
      for (int tt = 0; tt < 2; ++tt)
#pragma unroll
          for (int ks = 0; ks < 4; ++ks) { const bf16x8 a = trfrag(KTL + tt * 16384 + lb, db, ks);
#pragma unroll
              for (int j = 0; j < 4; ++j) acc[j] = __builtin_amdgcn_mfma_f32_32x32x16_bf16(a, trfrag(VTL + (tt * 2 + eb) * 16384 + lb, j, ks), acc[j], 0, 0, 0); }
      bf16* ST = WSP(bf16, WS_ST) + (size_t)unit * (128 * 256);
#pragma unroll
      for (int r = 0; r < 16; ++r) { const int d = db * 32 + crow_(r, hi); const float sc = __builtin_amdgcn_exp2f(1.4426950408889634f * (CAR[d] + CAR[128 + d]));
#pragma unroll
          for (int j = 0; j < 4; ++j) { const float v = acc[j][r] * sc, vn = __shfl_xor(v, 1); if ((r32 & 1) == 0) *(GAS unsigned*)(ST + (size_t)d * 256 + (eb * 4 + j) * 32 + r32) = pk2(v, vn); } }
      if (tid < 128) WSP(float, WS_DEC)[(size_t)unit * 128 + tid] = __builtin_amdgcn_exp2f(1.4426950408889634f * (CAR[tid] + CAR[128 + tid]));
    }
    __syncthreads();
}
__device__ __forceinline__ void gla_scan_phase(Frame& F, int dummy = 0) {
    const int gid = F.vcu * 512 + F.tid; if (gid >= 8 * 128 * 128) return;
    const int bh = gid >> 14, d = (gid >> 7) & 127, e2 = gid & 127;
    GAS unsigned* p = (GAS unsigned*)(WSP(bf16, WS_ST) + (size_t)bh * GNC * (128 * 256) + (size_t)d * 256 + 2 * e2); const float* dec = WSP(float, WS_DEC) + (size_t)bh * GNC * 128 + d;
    float s0 = 0.f, s1 = 0.f;
#pragma unroll 8
    for (int c = 0; c < GNC; ++c) { const unsigned w = p[(size_t)c * (128 * 256 / 2)]; const float dc = dec[c * 128];
        { GAS unsigned* pw = dummy ? (GAS unsigned*)WSP(bf16, 245 * MiB) + (gid & 0xfffff) : p + (size_t)c * (128 * 256 / 2); *pw = pk2(s0, s1); } s0 = dc * s0 + pg8::bflo(w); s1 = dc * s1 + pg8::bfhi(w); }
}
__device__ __forceinline__ void gla_out_unit(Frame& F, int unit, const float* g_gla_out, int dummy = 0) {
    const int tid = F.tid, lane = F.lane, wave = F.wave, r32 = lane & 31, hi = lane >> 5;
    const int bh = unit / GNC, c = unit % GNC, b = bh >> 2, h = bh & 3; const size_t tok0 = (size_t)b * SEQ + (size_t)c * GC;
    LAS unsigned char* lds = F.lds;
    LAS unsigned char* QL = lds;
    LAS unsigned char* KA = lds + 34816;
    LAS unsigned char* VH = lds + 69632;
    LAS unsigned char* SH = lds + 102400;
    LAS float* XS = (LAS float*)(lds + EXCH_OFF);
    const bf16* GQ = WSP(bf16, WS_GQ); const bf16* GK = WSP(bf16, WS_GK); bf16* GV = WSP(bf16, WS_GV); const bf16* ST = WSP(bf16, WS_ST) + (size_t)unit * (128 * 256);
#pragma unroll
    for (int j = 0; j < 4; ++j) { const int it = tid + 512 * j, t = it >> 4, ch = it & 15; const size_t go = (tok0 + t) * 512 + h * 128 + ch * 8;
        *(LAS v4u*)(QL + t * GSTR + ch * 16) = *(const GAS v4u*)(GQ + go); *(LAS v4u*)(KA + t * GSTR + ch * 16) = *(const GAS v4u*)(GK + go); }
    __syncthreads();
    const int ib = wave >> 1; f32x16 aa[2];
#pragma unroll
    for (int q = 0; q < 2; ++q) { const int jb = 2 * (wave & 1) + q; aa[q] = f32x16{};
        if (jb <= ib) { mm32(aa[q], KA + jb * 32 * GSTR, QL + ib * 32 * GSTR, r32, hi, 0, 8);
            if (jb == ib) {
#pragma unroll
                for (int r = 0; r < 16; ++r) if (crow_(r, hi) > r32) aa[q][r] = 0.f; } } }
    __syncthreads();
#pragma unroll
    for (int q = 0; q < 2; ++q) { const int jb = 2 * (wave & 1) + q;
#pragma unroll
        for (int g = 0; g < 4; ++g) { const unsigned lo = pg8::cvt_pk_bf16(aa[q][4 * g], aa[q][4 * g + 1]), hi2 = pg8::cvt_pk_bf16(aa[q][4 * g + 2], aa[q][4 * g + 3]);
            typedef unsigned u32x2v __attribute__((ext_vector_type(2)));
            *(LAS u32x2v*)(KA + (ib * 32 + r32) * GSTR + (jb * 32 + 8 * g + 4 * hi) * 2) = (u32x2v){lo, hi2}; } }
    const int ob = wave & 3, lb = att::v_rd_base(lane); f32x16 oo[4];
#pragma unroll
    for (int hf = 0; hf < 2; ++hf) {
#pragma unroll
        for (int j = 0; j < 4; ++j) { const int it = tid + 512 * j, t = it >> 4, ch = it & 15; const int dst = (t >> 6) * 16384 + att::v_st(t & 63, ch * 8);
            *(LAS v4u*)(VH + dst) = *(const GAS v4u*)(GV + (tok0 + t) * 1024 + h * 256 + hf * 128 + ch * 8);
            *(LAS v4u*)(SH + dst) = *(const GAS v4u*)(ST + (size_t)t * 256 + hf * 128 + ch * 8); }
        __syncthreads();
#pragma unroll
        for (int q = 0; q < 2; ++q) { const int eb = (wave >> 2) * 2 + q; f32x16 a = f32x16{};
            const LAS unsigned char* xa = KA + (ob * 32 + r32) * GSTR + hi * 16; const LAS unsigned char* xq = QL + (ob * 32 + r32) * GSTR + hi * 16;
            for (int ks = 0; ks < 2 * (ob + 1); ++ks) a = __builtin_amdgcn_mfma_f32_32x32x16_bf16(*(const LAS bf16x8*)(xa + ks * 32), trfrag(VH + (ks >> 2) * 16384 + lb, eb, ks & 3), a, 0, 0, 0);
#pragma unroll
            for (int ks = 0; ks < 8; ++ks) a = __builtin_amdgcn_mfma_f32_32x32x16_bf16(*(const LAS bf16x8*)(xq + ks * 32), trfrag(SH + (ks >> 2) * 16384 + lb, eb, ks & 3), a, 0, 0, 0);
            oo[hf * 2 + q] = a; }
        __syncthreads();
    }
    float ssr[16];
#pragma unroll
    for (int r = 0; r < 16; ++r) { float s = oo[0][r] * oo[0][r] + oo[1][r] * oo[1][r] + oo[2][r] * oo[2][r] + oo[3][r] * oo[3][r];
#pragma unroll
        for (int o = 1; o < 32; o <<= 1) s += __shfl_xor(s, o);
        ssr[r] = s; if (r32 == 0) XS[wave * 32 + hi * 16 + r] = s; }
    __syncthreads();
#pragma unroll
    for (int r = 0; r < 16; ++r) { const float tot = ssr[r] + XS[(wave ^ 4) * 32 + hi * 16 + r]; const float rs = __builtin_amdgcn_rsqf(tot * (1.f / 256.f) + EPS); const int t = ob * 32 + crow_(r, hi);
#pragma unroll
        for (int k = 0; k < 4; ++k) { const int e = (k >> 1) * 128 + ((wave >> 2) * 2 + (k & 1)) * 32 + r32; const float v = oo[k][r] * rs * g_gla_out[e], vn = __shfl_xor(v, 1);
            if ((r32 & 1) == 0) { bf16* GVw = dummy ? WSP(bf16, 245 * MiB) : GV; const size_t tw = dummy ? ((tok0 + t) & 2047) : (tok0 + t); *(GAS unsigned*)(GVw + tw * 1024 + h * 256 + e) = pk2(v, vn); } } }
    __syncthreads();
}

struct MlaSrc {
    const char *KN, *KPE, *VM; bf16* O; int h, orow0; unsigned offA, offP, ldsA, ldsP, vst0, vst1;
    __device__ __forceinline__ void init(int tid) { offA = (unsigned)((tid >> 4) * 2048 + (tid & 15) * 16); offP = (unsigned)((tid >> 3) * 128 + (tid & 7) * 16);
        ldsA = (unsigned)((tid >> 4) * 400 + (tid & 15) * 16); ldsP = (unsigned)((tid >> 3) * 400 + 256 + (tid & 7) * 16); vst0 = (unsigned)att::v_st(tid >> 4, (tid & 15) * 8); vst1 = (unsigned)att::v_st(32 + (tid >> 4), (tid & 15) * 8); }
    __device__ __forceinline__ void load(int t, att::u32x4 (&sk)[3], att::u32x4 (&sv)[2]) const {
        const char* kb = KN + (size_t)t * (64 * 2048); const char* vb = VM + (size_t)t * (64 * 2048); const char* pb = KPE + (size_t)t * (64 * 128);
        sk[0] = *(const GAS att::u32x4*)(kb + offA); sk[1] = *(const GAS att::u32x4*)(kb + 32 * 2048 + offA); sk[2] = *(const GAS att::u32x4*)(pb + offP);
        sv[0] = *(const GAS att::u32x4*)(vb + offA); sv[1] = *(const GAS att::u32x4*)(vb + 32 * 2048 + offA);
    }
    __device__ __forceinline__ void write(LAS char* kbuf, LAS char* vbuf, const att::u32x4 (&sk)[3], const att::u32x4 (&sv)[2]) const {
        *(LAS att::u32x4*)(kbuf + ldsA) = sk[0]; *(LAS att::u32x4*)(kbuf + ldsA + 32 * 400) = sk[1]; *(LAS att::u32x4*)(kbuf + ldsP) = sk[2];
        *(LAS att::u32x4*)(vbuf + vst0) = sv[0]; *(LAS att::u32x4*)(vbuf + vst1) = sv[1];
    }
    unsigned rmask;
    __device__ __forceinline__ void store(int orow, int col, float v, float vn) const { *(GAS unsigned*)(O + (size_t)((orow0 + orow) & rmask) * 1536 + h * 192 + col) = pk2(v, vn); }
};
__device__ __forceinline__ void mla_unit(Frame& F, int b, int h, int qb, const float* g_q_nope, const float* g_q_rope, int dummy = 0) {
    const int lane = F.lane, r32 = lane & 31, hi = lane >> 5, wid = F.wave;
    bf16* Q = WSP(bf16, WS_Q); const float* COS = WSP(float, WS_ROPE); const float* SIN = COS + (size_t)M * 32;
    const size_t rowbase = (size_t)b * SEQ; const int row = qb * 256 + wid * 32 + r32; const size_t grow = rowbase + row;
    att::bf16x8 qr[12];
    { f32x4 v[12][2]; float sn = 0.f, sr = 0.f;
#pragma unroll
      for (int d0 = 0; d0 < 12; ++d0) { pg8::unpack8bf(*(const GAS v4u*)(Q + grow * 1536 + h * 192 + d0 * 16 + hi * 8), v[d0][0], v[d0][1]);
          const f32x4 q = v[d0][0] * v[d0][0] + v[d0][1] * v[d0][1]; const float s = (q[0] + q[1]) + (q[2] + q[3]); if (d0 < 8) sn += s; else sr += s; }
      { auto rr = __builtin_amdgcn_permlane32_swap(__float_as_uint(sn), __float_as_uint(sn), false, false); sn = __uint_as_float(rr[0]) + __uint_as_float(rr[1]); }
      { auto rr = __builtin_amdgcn_permlane32_swap(__float_as_uint(sr), __float_as_uint(sr), false, false); sr = __uint_as_float(rr[0]) + __uint_as_float(rr[1]); }
      const float rn = __builtin_amdgcn_rsqf(sn * (1.f / 128.f) + EPS) * QK_SCALE_L2, rr_ = __builtin_amdgcn_rsqf(sr * (1.f / 64.f) + EPS) * QK_SCALE_L2;
#pragma unroll
      for (int d0 = 0; d0 < 8; ++d0) { const f32x4 g0 = *(const f32x4*)(g_q_nope + d0 * 16 + hi * 8), g1 = *(const f32x4*)(g_q_nope + d0 * 16 + hi * 8 + 4); qr[d0] = att::pack8(v[d0][0] * rn * g0, v[d0][1] * rn * g1); }
#pragma unroll
      for (int p = 0; p < 2; ++p) {
          const int i0 = 16 * p + 8 * hi;
          const f32x4 ga0 = *(const f32x4*)(g_q_rope + i0), ga1 = *(const f32x4*)(g_q_rope + i0 + 4), gb0 = *(const f32x4*)(g_q_rope + 32 + i0), gb1 = *(const f32x4*)(g_q_rope + 32 + i0 + 4);
          const f32x4 c0 = *(const f32x4*)(COS + grow * 32 + i0), c1 = *(const f32x4*)(COS + grow * 32 + i0 + 4), s0 = *(const f32x4*)(SIN + grow * 32 + i0), s1 = *(const f32x4*)(SIN + grow * 32 + i0 + 4);
          const f32x4 a0 = v[8 + p][0] * rr_ * ga0, a1 = v[8 + p][1] * rr_ * ga1, b0 = v[10 + p][0] * rr_ * gb0, b1 = v[10 + p][1] * rr_ * gb1;
          qr[8 + p] = att::pack8(a0 * c0 - b0 * s0, a1 * c1 - b1 * s1); qr[10 + p] = att::pack8(a0 * s0 + b0 * c0, a1 * s1 + b1 * c1); }
    }
    MlaSrc S; S.KN = (const char*)F.out + (rowbase * 1024 + h * 128) * 2; S.VM = (const char*)F.out + ((size_t)M * 1024 + rowbase * 1024 + h * 128) * 2; S.KPE = (const char*)WSP(bf16, WS_KPE) + rowbase * 128;
    S.O = dummy ? WSP(bf16, 245 * MiB) : Q; S.rmask = dummy ? 2047u : ~0u; S.h = h; S.orow0 = (int)(rowbase + qb * 256 + wid * 32); S.init(F.tid);
    att::attn_unit<192, 128, true, true, MlaSrc>((LAS char*)F.lds, qr, 4 * (qb + 1), wid * 32, S);
}
struct MemSrc {
    const char* KV; const float* gk; bf16* O; int hm, orow0; unsigned offK, offV, ldsK, vst0, vst1, gko;
    __device__ __forceinline__ void init(int tid) { offK = (unsigned)((tid >> 3) * 2560 + hm * 128 + (tid & 7) * 16); offV = (unsigned)((tid >> 4) * 2560 + 512 + hm * 512 + (tid & 15) * 16);
        ldsK = (unsigned)((tid >> 3) * 144 + (tid & 7) * 16); vst0 = (unsigned)att::v_st(tid >> 4, (tid & 15) * 8); vst1 = (unsigned)att::v_st(32 + (tid >> 4), (tid & 15) * 8); gko = (unsigned)((tid & 7) * 8); }
    __device__ __forceinline__ void load(int t, att::u32x4 (&sk)[1], att::u32x4 (&sv)[4]) const {
        const char* kb = KV + (size_t)t * (64 * 2560);
        f32x4 a0, a1; pg8::unpack8bf(*(const GAS att::u32x4*)(kb + offK), a0, a1);
        const f32x4 q = a0 * a0 + a1 * a1; float s = (q[0] + q[1]) + (q[2] + q[3]); s += __shfl_xor(s, 1); s += __shfl_xor(s, 2); s += __shfl_xor(s, 4);
        const float rs = __builtin_amdgcn_rsqf(s * (1.f / 64.f) + EPS);
        sk[0] = pg8::pack8bf(a0 * rs * *(const f32x4*)(gk + gko), a1 * rs * *(const f32x4*)(gk + gko + 4));
        sv[0] = *(const GAS att::u32x4*)(kb + offV); sv[1] = *(const GAS att::u32x4*)(kb + 32 * 2560 + offV); sv[2] = *(const GAS att::u32x4*)(kb + 256 + offV); sv[3] = *(const GAS att::u32x4*)(kb + 32 * 2560 + 256 + offV);
    }
    __device__ __forceinline__ void write(LAS char* kbuf, LAS char* vbuf, const att::u32x4 (&sk)[1], const att::u32x4 (&sv)[4]) const {
        *(LAS att::u32x4*)(kbuf + ldsK) = sk[0];
        *(LAS att::u32x4*)(vbuf + vst0) = sv[0]; *(LAS att::u32x4*)(vbuf + vst1) = sv[1]; *(LAS att::u32x4*)(vbuf + 16384 + vst0) = sv[2]; *(LAS att::u32x4*)(vbuf + 16384 + vst1) = sv[3];
    }
    __device__ __forceinline__ void store(int orow, int col, float v, float vn) const { *(GAS unsigned*)(O + (size_t)(orow0 + orow) * 1024 + hm * 256 + col) = pk2(v, vn); }
};
__device__ __forceinline__ void mem_unit(Frame& F, int pm, int hm, const float* g_q_mem, const float* g_k_mem) {
    const int lane = F.lane, r32 = lane & 31, hi = lane >> 5, wid = F.wave;
    const bf16* QM = WSP(bf16, WS_QMEM); const size_t grow = (size_t)pm * 256 + wid * 32 + r32;
    att::bf16x8 qr[4];
    { f32x4 v[4][2]; float sn = 0.f;
#pragma unroll
      for (int d0 = 0; d0 < 4; ++d0) { pg8::unpack8bf(*(const GAS v4u*)(QM + grow * 256 + hm * 64 + d0 * 16 + hi * 8), v[d0][0], v[d0][1]); const f32x4 q = v[d0][0] * v[d0][0] + v[d0][1] * v[d0][1]; sn += (q[0] + q[1]) + (q[2] + q[3]); }
      { auto rr = __builtin_amdgcn_permlane32_swap(__float_as_uint(sn), __float_as_uint(sn), false, false); sn = __uint_as_float(rr[0]) + __uint_as_float(rr[1]); }
      const float rn = __builtin_amdgcn_rsqf(sn * (1.f / 64.f) + EPS) * MEM_SCALE_L2;
#pragma unroll
      for (int d0 = 0; d0 < 4; ++d0) { const f32x4 g0 = *(const f32x4*)(g_q_mem + d0 * 16 + hi * 8), g1 = *(const f32x4*)(g_q_mem + d0 * 16 + hi * 8 + 4); qr[d0] = att::pack8(v[d0][0] * rn * g0, v[d0][1] * rn * g1); } }
    MemSrc S; S.KV = (const char*)WSP(bf16, WS_KVM) + (size_t)(pm / 32) * (MEM_LEN * 2560); S.gk = g_k_mem; S.O = (bf16*)F.out; S.hm = hm; S.orow0 = pm * 256 + wid * 32; S.init(F.tid);
    att::attn_unit<64, 256, false, false, MemSrc>((LAS char*)F.lds, qr, 4, 0, S);
}

struct Args { const void* in[23]; float* out; unsigned char* ws; RopeArg rope; int ph_lo, ph_hi, li, pad; };
__global__ void __launch_bounds__(NWAVES * 64, 2) hybrid_fwd(Args args) {
    extern __shared__ __attribute__((aligned(16))) unsigned char lds[];
    Frame F;
    F.lds = (LAS unsigned char*)lds;
    F.MISC = (volatile LAS unsigned*)(F.lds + MISC_OFF);
    F.tid = threadIdx.x; F.lane = F.tid & 63; F.wave = __builtin_amdgcn_readfirstlane(F.tid >> 6);
    F.G = gridDim.x; { const int bx = blockIdx.x; F.vcu = (F.G % 8 == 0) ? (bx % 8) * (F.G / 8) + bx / 8 : bx; }
    F.ws = args.ws; F.out = args.out; F.ctl = (gu32*)(args.ws + WS_CTL);
#define INF(k) ((const float*)args.in[k])
    for (int u = F.tid; u < (LDS_BYTES - LDSCTL_OFF) / 4; u += NWAVES * 64) ((LAS unsigned*)(F.lds + LDSCTL_OFF))[u] = 0u;
    __syncthreads();
    XcdBarrier bar; bar.bar = (unsigned*)(F.ctl + CW_BAR); bar.x = 0; bar.st = nullptr;
    if (N_LAUNCHES != PER_PHASE) bar = xcd_barrier_post((unsigned*)(F.ctl + CW_BAR), F.MISC + 8);
#define GRID_BAR(seam) do { if (N_LAUNCHES == PER_PHASE) { if (F.tid == 0) __hip_atomic_store(F.ctl + CW_TMO, 0xBADBA0u | (unsigned)(seam), RLX_AGENT); } else { xcd_barrier(bar); } } while (0)
    const int lo = args.ph_lo, hi = args.ph_hi; const bool dm = args.pad != 0;
#ifndef PHMASK
#define PHMASK 0x1fff
#endif
#define IN(k) (((PHMASK >> (k)) & 1) && lo <= (k) && (k) < hi)
#define BOTH(k) (IN(k) && IN((k) + 1))
    bf16* const Win_t = WSP(bf16, WS_WIN); bf16* const XN = WSP(bf16, WS_XN);
    bf16* const KN = (bf16*)F.out; bf16* const VM = (bf16*)F.out + (size_t)M * 1024; bf16* const OMEM = (bf16*)F.out; bf16* const Y = WSP(bf16, WS_GQ);

    if (IN(0)) { const P0In I{INF(0), INF(1), (const int*)args.in[2], INF(3), INF(4), INF(6), INF(7), INF(15), INF(16), INF(19), INF(21), INF(22)}; p0_prologue(F, I, args.rope); if (BOTH(0)) GRID_BAR(0); }
    if (IN(1)) {
        pg8::Gemm g{XN, Win_t, M + MROWS, NPAD + 1280, D}; pg8::ProjOrder S; S.init(M, NP1, F.G, (int)blockIdx.x);
        pg8::EpiProj E{WSP(bf16, WS_Q), WSP(bf16, WS_CKV), WSP(bf16, WS_KRAG), WSP(bf16, WS_GQ), WSP(bf16, WS_GK), WSP(bf16, WS_GV), WSP(bf16, WS_QMEM), WSP(bf16, WS_KVM)};
        pg8::gemm_phase<pg8::EpiProj, pg8::ProjOrder, true, true>(F.lds + RING_OFF, g, S, E);
        if (BOTH(1)) GRID_BAR(1);
    }
    if (IN(2)) {
        { pg8::Gemm g{WSP(bf16, WS_CKV), WSP(bf16, WS_WUKV), M, 2048, 256}; pg8::StaticOrder S; S.init(M, 2048, F.G, (int)blockIdx.x);
          pg8::EpiKvUp E{WSP(bf16, WS_CKV), KN, VM, INF(9), (LAS float*)(F.lds + EXCH_OFF), EPS};
          pg8::gemm_phase<pg8::EpiKvUp, pg8::StaticOrder, true, true>(F.lds + RING_OFF, g, S, E); }
        __syncthreads();
        kpe_phase(F, INF(11));
    }
    if (IN(3)) {
        for (int u = F.vcu; u < BATCH * 4 * GNC; u += F.G) gla_local_unit(F, u, INF(12), INF(13), dm);
        if (BOTH(3)) GRID_BAR(3);
    }
    if (IN(4)) gla_scan_phase(F, dm);
    if (IN(5)) {
        for (int it = F.vcu; it < BATCH * 8 * 16; it += F.G) { const int bh = it >> 4, s = it & 15; mla_unit(F, bh >> 3, bh & 7, s, INF(8), INF(10), dm); mla_unit(F, bh >> 3, bh & 7, 31 - s, INF(8), INF(10), dm); }
        if (BOTH(5)) GRID_BAR(5);
    }
    if (IN(6)) for (int u = F.vcu; u < BATCH * 4 * GNC; u += F.G) gla_out_unit(F, u, INF(14), dm);
    if (IN(7)) {
        for (int u = F.vcu; u < 64 * 4; u += F.G) mem_unit(F, u >> 2, u & 3, INF(17), INF(18));
        if (BOTH(7)) GRID_BAR(7);
    }
    if (IN(8)) {
        pg8::Gemm g{XN, Win_t, M, NPAD, D}; pg8::MergeOrder S; S.init(M, 1024, F.G, (int)blockIdx.x);
        pg8::EpiMerge E{INF(5), WSP(bf16, WS_Q), WSP(bf16, WS_GV), OMEM, dm ? WSP(bf16, 245 * MiB) : Y, dm ? WSP(bf16, 245 * MiB) : WSP(bf16, WS_Q), dm ? WSP(bf16, 245 * MiB) : WSP(bf16, WS_GV), dm ? 2047u : ~0u};
        pg8::gemm_phase<pg8::EpiMerge, pg8::MergeOrder, true, true>(F.lds + RING_OFF, g, S, E);
        if (BOTH(8)) GRID_BAR(8);
    }
    if (IN(9)) {
        pg8::Gemm g{Y, WSP(bf16, WS_WO), M, D, D}; pg8::StaticOrder S; S.init(M, D, F.G, (int)blockIdx.x);
        pg8::EpiResF32 E{INF(0), F.out, D, ~0u};
        pg8::gemm_phase<pg8::EpiResF32, pg8::StaticOrder, true, true>(F.lds + RING_OFF, g, S, E);
        if (BOTH(9)) GRID_BAR(9);
    }
    if (IN(10)) {
        const int gw = F.vcu * NWAVES + F.wave, NGW = F.G * NWAVES;
        for (int m = gw; m < M; m += NGW) rms_row_to_bf16(F.lane, F.out + (size_t)m * D, INF(20), XN + (size_t)m * D);
        if (BOTH(10)) GRID_BAR(10);
    }
    if (IN(11)) {
        pg8::Gemm g{XN, WSP(bf16, WS_WUP), M, FF, D}; pg8::StaticOrder S; S.init(M, FF, F.G, (int)blockIdx.x);
        pg8::EpiRelu2 E{WSP(bf16, WS_H), FF};
        pg8::gemm_phase<pg8::EpiRelu2, pg8::StaticOrder, true, true>(F.lds + RING_OFF, g, S, E);
        if (BOTH(11)) GRID_BAR(11);
    }
    if (IN(12)) {
        pg8::Gemm g{WSP(bf16, WS_H), WSP(bf16, WS_WDN), M, D, FF}; pg8::StaticOrder S; S.init(M, D, F.G, (int)blockIdx.x);
        pg8::EpiResF32 E{F.out, dm ? WSP(float, 245 * MiB) : F.out, D, dm ? 2047u : ~0u};
        pg8::gemm_phase<pg8::EpiResF32, pg8::StaticOrder, true, true>(F.lds + RING_OFF, g, S, E);
    }
#undef IN
#undef BOTH
}

extern "C" void kernel_launch(void* const* d_in, const int* in_sizes, int n_in, void* d_out, int out_size, void* d_ws, size_t ws_size, hipStream_t stream) {
    static int grid = 0;
    if (grid == 0) {
        if (n_in != 23 || in_sizes[0] != M * D || out_size != M * D || ws_size < WS_END) { fprintf(stderr, "kernel_launch: shape mismatch (n_in %d in0 %d out %d ws %zu)\n", n_in, n_in > 0 ? in_sizes[0] : -1, out_size, ws_size); grid = -1; return; }
        int dev = 0, cus = 0;
        if (hipGetDevice(&dev) != hipSuccess || hipDeviceGetAttribute(&cus, hipDeviceAttributeMultiprocessorCount, dev) != hipSuccess) { grid = -1; return; }
        if (hipFuncSetAttribute((const void*)hybrid_fwd, hipFuncAttributeMaxDynamicSharedMemorySize, LDS_BYTES) != hipSuccess) { fprintf(stderr, "kernel_launch: hipFuncSetAttribute failed\n"); grid = -1; return; }
        int per_cu = 0;
        if (hipOccupancyMaxActiveBlocksPerMultiprocessor(&per_cu, (const void*)hybrid_fwd, NWAVES * 64, LDS_BYTES) != hipSuccess || per_cu < 1) fprintf(stderr, "kernel_launch: occupancy query says %d\n", per_cu);
        (void)hipGetLastError();
        grid = cus;
        if (grid != 256) fprintf(stderr, "kernel_launch: %d CUs (built for 256)\n", grid);
    }
    if (grid < 0) return;
    (void)hipMemsetAsync((char*)d_ws + WS_CTL, 0, CTL_ZERO_BYTES, stream);
    Args a{};
    for (int i = 0; i < 23; ++i) a.in[i] = d_in[i];
    a.out = (float*)d_out; a.ws = (unsigned char*)d_ws;
    for (int i = 0; i < 32; ++i) a.rope.inv_rev[i] = pow(10000.0, -(double)(2 * i) / 64.0) / 6.283185307179586476925286766559;
    if (N_LAUNCHES == 1) { a.ph_lo = 0; a.ph_hi = PER_PHASE; a.li = 0; hipLaunchKernelGGL(hybrid_fwd, dim3(grid), dim3(NWAVES * 64), LDS_BYTES, stream, a); }
    else for (int li = 0; li < PER_PHASE; ++li) { a.ph_lo = li; a.ph_hi = li + 1; a.li = li;
#ifdef PROBE_PHASE
        if (li == PROBE_PHASE) { a.pad = 1; hipLaunchKernelGGL(hybrid_fwd, dim3(grid), dim3(NWAVES * 64), LDS_BYTES, stream, a); a.pad = 0; }
#endif
        hipLaunchKernelGGL(hybrid_fwd, dim3(grid), dim3(NWAVES * 64), LDS_BYTES, stream, a); }
}
```
